# Optimizing an MI355X kernel written in HIP

```python
import math
import jax, jax.numpy as jnp
from jax import lax
import numpy as np

D_MODEL = 1024
BATCH = 1
SEQ = 16384
DEPTH = 1

N_HEADS = 8
HEAD_DIM = 64
ATTN_WIDTH = N_HEADS * HEAD_DIM
ATTN_SCALE = HEAD_DIM ** -0.5
IDX_HEADS = 8
IDX_DIM = 64
IDX_SCALE = (IDX_HEADS ** -0.5) * (IDX_DIM ** -0.5)
TOPK_MAX = 256
Q_BLOCK = 128
CONV_CH = 512
CONV_WIDTH = 31
N_BRANCH = 2
N_BUCKETS = 32
MAX_DISTANCE = 128
N_EXPERTS = 32
TOP_K_EXPERTS = 4
D_EXPERT = 1024
SWIGLU_LIMIT = 7.0
SWIGLU_ALPHA = 1.702
PLE_DIM = 256
LN_EPS = 1e-5
DEEPNORM_ALPHA = (2 * DEPTH) ** 0.25
DEEPNORM_BETA = (8 * DEPTH) ** -0.25

IN_SPLITS = [ATTN_WIDTH, ATTN_WIDTH, ATTN_WIDTH, IDX_HEADS * IDX_DIM, IDX_DIM, IDX_HEADS,
             2 * CONV_CH, D_MODEL, D_MODEL]
IN_COLS = sum(IN_SPLITS)

kernel_name = "hybrid_dsa_conformer_moe_block"


def layer_norm(x, g, b):
    xf = x.astype(jnp.float32)
    mu = jnp.mean(xf, axis=-1, keepdims=True)
    var = jnp.mean(jnp.square(xf - mu), axis=-1, keepdims=True)
    return ((xf - mu) * lax.rsqrt(var + LN_EPS) * g.astype(jnp.float32) + b.astype(jnp.float32)).astype(x.dtype)


def t5_bucket(rel):
    max_exact = N_BUCKETS // 2
    rel_f = jnp.maximum(rel, 1).astype(jnp.float32)
    large = max_exact + (jnp.log(rel_f / max_exact) / math.log(MAX_DISTANCE / max_exact)
                         * (N_BUCKETS - max_exact)).astype(jnp.int32)
    large = jnp.minimum(large, N_BUCKETS - 1)
    return jnp.where(rel < max_exact, rel, large)


def dsa_attention(q, k, v, q_idx, k_idx, w_idx, rel_bias):
    B, S = q.shape[0], q.shape[1]
    top_k = min(TOPK_MAX, S // 4)
    n_blocks = S // Q_BLOCK
    key_pos = jnp.arange(S, dtype=jnp.int32)
    gather_rows = jax.vmap(lambda arr, idx: arr[idx])

    def block(i):
        start = i * Q_BLOCK
        q_pos = start + jnp.arange(Q_BLOCK, dtype=jnp.int32)
        qb = lax.dynamic_slice_in_dim(q, start, Q_BLOCK, axis=1)
        qib = lax.dynamic_slice_in_dim(q_idx, start, Q_BLOCK, axis=1)
        wb = lax.dynamic_slice_in_dim(w_idx, start, Q_BLOCK, axis=1)
        dots = jnp.einsum('bqhd,bsd->bqhs', qib, k_idx, preferred_element_type=jnp.float32)
        score = jnp.einsum('bqh,bqhs->bqs', wb.astype(jnp.float32) * IDX_SCALE, jax.nn.relu(dots))
        causal = key_pos[None, :] <= q_pos[:, None]
        score = jnp.where(causal[None], score, -jnp.inf)
        _, sel = lax.top_k(score, top_k)
        valid = sel <= q_pos[None, :, None]
        k_sel = gather_rows(k, sel)
        v_sel = gather_rows(v, sel)
        rel = jnp.maximum(q_pos[None, :, None] - sel, 0)
        bias = jnp.transpose(rel_bias[t5_bucket(rel)], (0, 3, 1, 2))
        logits = jnp.einsum('bqhd,bqkhd->bhqk', qb, k_sel,
                            preferred_element_type=jnp.float32) * ATTN_SCALE + bias.astype(jnp.float32)
        logits = jnp.where(valid[:, None], logits, -jnp.inf)
        probs = jax.nn.softmax(logits, axis=-1)
        return jnp.einsum('bhqk,bqkhd->bqhd', probs.astype(v.dtype), v_sel)

    out = lax.map(block, jnp.arange(n_blocks, dtype=jnp.int32))
    return jnp.transpose(out, (1, 0, 2, 3, 4)).reshape(B, S, ATTN_WIDTH)


def conformer_conv(conv_in, w_dw, b_dw, ln_g, ln_b):
    a, g = jnp.split(conv_in, 2, axis=-1)
    u = a * jax.nn.sigmoid(g)
    y = lax.conv_general_dilated(u, w_dw[:, None, :], window_strides=(1,),
                                 padding=((CONV_WIDTH - 1, 0),),
                                 dimension_numbers=('NWC', 'WIO', 'NWC'),
                                 feature_group_count=CONV_CH) + b_dw
    y = layer_norm(y, ln_g, ln_b)
    return jax.nn.silu(y)


def mixing_sublayer(x, w_in, b_in, w_o_attn, w_dw, b_dw, conv_ln_g, conv_ln_b, w_o_conv, w_out, rel_bias):
    B, S, _ = x.shape
    proj = x @ w_in + b_in
    offsets = np.cumsum(IN_SPLITS)[:-1].tolist()
    q, k, v, qi, ki, wi, conv_in, g_attn, g_conv = jnp.split(proj, offsets, axis=-1)
    q = q.reshape(B, S, N_HEADS, HEAD_DIM)
    k = k.reshape(B, S, N_HEADS, HEAD_DIM)
    v = v.reshape(B, S, N_HEADS, HEAD_DIM)
    qi = qi.reshape(B, S, IDX_HEADS, IDX_DIM)
    y_attn = dsa_attention(q, k, v, qi, ki, wi, rel_bias) @ w_o_attn
    y_conv = conformer_conv(conv_in, w_dw, b_dw, conv_ln_g, conv_ln_b) @ w_o_conv
    merged = jax.nn.sigmoid(g_attn) * y_attn + jax.nn.sigmoid(g_conv) * y_conv
    return merged @ w_out


def moe_ffn(h, w_router, b_router, w_gate_up, b_gate_up, w_down, b_down):
    B, S, D = h.shape
    t = h.reshape(B * S, D)
    logits = (t @ w_router + b_router).astype(jnp.float32)
    top_vals, top_idx = lax.top_k(logits, TOP_K_EXPERTS)
    gates = jax.nn.softmax(top_vals, axis=-1)
    rows = jnp.arange(B * S)[:, None]
    combine = jnp.zeros((B * S, N_EXPERTS), jnp.float32).at[rows, top_idx].set(gates)
    out = jnp.zeros_like(t)
    for e in range(N_EXPERTS):
        gu = t @ w_gate_up[e] + b_gate_up[e]
        g, u = gu[:, :D_EXPERT], gu[:, D_EXPERT:]
        g = jnp.minimum(g, SWIGLU_LIMIT)
        u = jnp.clip(u, -SWIGLU_LIMIT, SWIGLU_LIMIT)
        act = (u + 1) * (g * jax.nn.sigmoid(SWIGLU_ALPHA * g))
        y = act @ w_down[e] + b_down[e]
        out = out + combine[:, e:e + 1].astype(t.dtype) * y
    return out.reshape(B, S, D)


def setup_inputs(seed: int = 0) -> dict:
    key = jax.random.key(seed)
    ks = jax.random.split(key, 26)
    f32 = jnp.float32

    def nrm(k, shape, fan_in, scale=1.0):
        return jax.random.normal(k, shape, f32) * (scale * fan_in ** -0.5)

    def small(k, shape, s=0.02):
        return jax.random.normal(k, shape, f32) * s

    L = DEPTH
    return {
        "x": jax.random.normal(ks[0], (BATCH, SEQ, D_MODEL), f32),
        "p": jax.random.normal(ks[1], (DEPTH, BATCH, SEQ, PLE_DIM), f32),
        "w_in": nrm(ks[2], (L, D_MODEL, IN_COLS), D_MODEL),
        "b_in": small(ks[3], (L, IN_COLS)),
        "w_o_attn": nrm(ks[4], (L, ATTN_WIDTH, D_MODEL), ATTN_WIDTH),
        "w_dw": nrm(ks[5], (L, CONV_WIDTH, CONV_CH), CONV_WIDTH),
        "b_dw": small(ks[6], (L, CONV_CH)),
        "conv_ln_g": 1.0 + small(ks[7], (L, CONV_CH)),
        "conv_ln_b": small(ks[8], (L, CONV_CH)),
        "w_o_conv": nrm(ks[9], (L, CONV_CH, D_MODEL), CONV_CH),
        "w_out": nrm(ks[10], (L, D_MODEL, D_MODEL), D_MODEL, DEEPNORM_BETA),
        "ln1_g": 1.0 + small(ks[11], (L, D_MODEL)),
        "ln1_b": small(ks[12], (L, D_MODEL)),
        "w_router": nrm(ks[13], (L, D_MODEL, N_EXPERTS), D_MODEL),
        "b_router": small(ks[14], (L, N_EXPERTS), 0.01),
        "w_gate_up": nrm(ks[15], (L, N_EXPERTS, D_MODEL, 2 * D_EXPERT), D_MODEL),
        "b_gate_up": small(ks[16], (L, N_EXPERTS, 2 * D_EXPERT)),
        "w_down": nrm(ks[17], (L, N_EXPERTS, D_EXPERT, D_MODEL), D_EXPERT, DEEPNORM_BETA),
        "b_down": small(ks[18], (L, N_EXPERTS, D_MODEL)),
        "w_ple_gate": nrm(ks[19], (L, D_MODEL, D_MODEL), D_MODEL),
        "w_ple_proj": nrm(ks[20], (L, PLE_DIM, D_MODEL), PLE_DIM, DEEPNORM_BETA),
        "ln2_g": 1.0 + small(ks[21], (L, D_MODEL)),
        "ln2_b": small(ks[22], (L, D_MODEL)),
        "rel_bias": small(ks[23], (N_BUCKETS, N_HEADS), 0.5),
    }


def reference(x, p, w_in, b_in, w_o_attn, w_dw, b_dw, conv_ln_g, conv_ln_b, w_o_conv, w_out,
              ln1_g, ln1_b, w_router, b_router, w_gate_up, b_gate_up, w_down, b_down,
              w_ple_gate, w_ple_proj, ln2_g, ln2_b, rel_bias):
    for i in range(DEPTH):
        mix = mixing_sublayer(x, w_in[i], b_in[i], w_o_attn[i], w_dw[i], b_dw[i], conv_ln_g[i],
                              conv_ln_b[i], w_o_conv[i], w_out[i], rel_bias)
        x = layer_norm(DEEPNORM_ALPHA * x + mix, ln1_g[i], ln1_b[i])
        h = DEEPNORM_ALPHA * x + moe_ffn(x, w_router[i], b_router[i], w_gate_up[i], b_gate_up[i],
                                         w_down[i], b_down[i])
        ple = jax.nn.sigmoid(h @ w_ple_gate[i]) * (p[i] @ w_ple_proj[i])
        x = layer_norm(h + ple, ln2_g[i], ln2_b[i])
    return x
```

```cpp
#include <hip/hip_runtime.h>
#include <cstdio>
#include <cstdint>

namespace pg8 {
#define PG8_LAS __attribute__((address_space(3)))
typedef unsigned short bf16_t;
typedef short bf16x8 __attribute__((ext_vector_type(8)));
typedef float f32x4 __attribute__((ext_vector_type(4)));
typedef unsigned u32x4 __attribute__((ext_vector_type(4)));
typedef unsigned u32x2 __attribute__((ext_vector_type(2)));
constexpr int BM = 256, BK = 64, HALF = 128, HTB = HALF * BK * 2  , STAGE_BYTES = 8 * HTB, NXCD = 8, WGM = 8;

__host__ __device__ __forceinline__ int lds_byte(int r, int c) { const int st = (r >> 4) * 2 + (c >> 5), rr = r & 15, cc = c & 31, ob = rr * 64 + cc * 2; return st * 1024 + (ob ^ (((ob >> 9) & 1) << 5)); }
__host__ __device__ __forceinline__ void stage_rc(int b, int& R, int& C) { const int st = b / 1024, sb = b % 1024, swz = sb ^ (((sb >> 9) & 1) << 5); R = (st >> 1) * 16 + swz / 64; C = (st & 1) * 32 + (swz % 64) / 2; }
__host__ __device__ __forceinline__ int perm32(int rho) { const int n = rho >> 4, i = rho & 15; return 8 * (i >> 2) + 4 * n + (i & 3); }

struct Unit { int pm, pn, e; };
struct Gemm { const bf16_t* A; const bf16_t* Bt; int M, N, K; };

struct StaticOrder {
    static constexpr bool GATHER = false;
    int nM, nN, nwg, G, c;
    __host__ __device__ void init(int M, int N, int G_, int c_) { nM = M / BM; nN = N / BM; nwg = nM * nN; G = G_; c = c_; }
    __host__ __device__ bool next(int i, Unit& u) const {
        const long L = (long)i * G + c; if (L >= nwg) return false;
        int wgid = (int)L; { const int q = nwg / NXCD, r = nwg % NXCD, xcd = wgid % NXCD, off = wgid / NXCD; wgid = (xcd < r ? xcd * (q + 1) : r * (q + 1) + (xcd - r) * q) + off; }
        const int nig = WGM * nN, gid = wgid / nig, fm = gid * WGM, gsz = (nM - fm) < WGM ? (nM - fm) : WGM;
        u.pm = fm + ((wgid % nig) % gsz); u.pn = (wgid % nig) / gsz; u.e = 0; return true;
    }
    __device__ __forceinline__ const char* a_base(const Gemm& g, const Unit& u) const { return (const char*)g.A + (size_t)u.pm * ((size_t)BM * g.K * 2); }
    __device__ __forceinline__ const char* b_base(const Gemm& g, const Unit& u) const { return (const char*)g.Bt + (size_t)u.pn * ((size_t)BM * g.K * 2); }
    __device__ __forceinline__ unsigned a_rowoff(const Unit&, int, int) const { return 0u; }
};

typedef float f32x2_cv __attribute__((ext_vector_type(2))); typedef __bf16 bf16x2_cv __attribute__((ext_vector_type(2)));
__device__ __forceinline__ unsigned cvt_pk_bf16(float lo, float hi) { const f32x2_cv v = {lo, hi}; const bf16x2_cv b = __builtin_convertvector(v, bf16x2_cv); return __builtin_bit_cast(unsigned, b); }

template <class Epi, class Sched, bool ALIGN_EPI = false, bool SP2 = false>
__device__ __forceinline__ void gemm_phase(PG8_LAS unsigned char* lds, const Gemm g, const Sched& S, const Epi& E) {
    const int tid = threadIdx.x, wid = __builtin_amdgcn_readfirstlane(tid >> 6), lane = tid & 63, wr = wid >> 2, wc = wid & 3, fr = lane & 15, fq = lane >> 4;
    int K_ = g.K; asm volatile("" : "+s"(K_));
    const int K = K_, nt = K / BK;
    constexpr bool GATHER = Sched::GATHER;
    int Rr[2], Cc[2]; unsigned voffB[2];
#pragma unroll
    for (int i = 0; i < 2; ++i) { stage_rc(tid * 16 + i * 8192, Rr[i], Cc[i]); const int Rb = Epi::PERM ? ((Rr[i] & ~31) + perm32(Rr[i] & 31)) : Rr[i];
        voffB[i] = (unsigned)(Rb * K + Cc[i]) * 2u; }
    const size_t kstep = (size_t)(BK * 2);
    const size_t hstep = (size_t)HALF * K * 2;
    const unsigned ldsw = (unsigned)wid * 1024u;
    const int aoff = lds_byte(wr * 64 + fr, fq * 8), boff = lds_byte(wc * 32 + fr, fq * 8);
    unsigned vA[2][2], vN[2][2];
#define PG8_SETA(v, u) do { _Pragma("unroll") for (int _h = 0; _h < 2; ++_h) _Pragma("unroll") for (int _i = 0; _i < 2; ++_i) \
        v[_h][_i] = (GATHER ? S.a_rowoff(u, _h, Rr[_i]) : (unsigned)((_h * HALF + Rr[_i]) * K) * 2u) + (unsigned)Cc[_i] * 2u; } while (0)
#define PG8_SA(b, h) (((b) * 2 + (h)) * HTB)
#define PG8_SB(b, h) ((4 + (b) * 2 + (h)) * HTB)
#define PG8_STAGE(bufoff, gbase, voff) do { _Pragma("unroll") for (int _i = 0; _i < 2; ++_i) \
        __builtin_amdgcn_global_load_lds((const unsigned*)((const char*)(gbase) + (voff)[_i]), (PG8_LAS unsigned*)(lds + (bufoff) + ldsw + _i * 8192), 16, 0, 0); } while (0)
#define PG8_LDA(dst, b, h) do { _Pragma("unroll") for (int m = 0; m < 4; ++m) _Pragma("unroll") for (int k = 0; k < 2; ++k) dst[m][k] = *(const PG8_LAS bf16x8*)(lds + PG8_SA(b, h) + aoff + m * 2048 + k * 1024); } while (0)
#define PG8_LDB(dst, b, h) do { _Pragma("unroll") for (int n = 0; n < 2; ++n) _Pragma("unroll") for (int k = 0; k < 2; ++k) dst[n][k] = *(const PG8_LAS bf16x8*)(lds + PG8_SB(b, h) + boff + n * 2048 + k * 1024); } while (0)
#define PG8_MMA(ai, bj, At, Bt) do { __builtin_amdgcn_s_setprio(1); _Pragma("unroll") for (int m = 0; m < 4; ++m) _Pragma("unroll") for (int n = 0; n < 2; ++n) _Pragma("unroll") for (int k = 0; k < 2; ++k) \
        acc[ai][bj][m][n] = __builtin_amdgcn_mfma_f32_16x16x32_bf16(Bt[n][k], At[m][k], acc[ai][bj][m][n], 0, 0, 0); __builtin_amdgcn_s_setprio(0); } while (0)
#define PG8_WAIT_V(n) asm volatile("s_waitcnt vmcnt(" #n ")" ::: "memory")
#define PG8_WAIT_L(n) asm volatile("s_waitcnt lgkmcnt(" #n ")" ::: "memory")
#define PG8_BAR __builtin_amdgcn_s_barrier()
#define PG8_SCHED __builtin_amdgcn_sched_barrier(0)
    Unit cur, nxt; int ui = 0;
    if (!S.next(0, cur)) return;
    f32x4 acc[2][2][4][2];
#pragma unroll
    for (int a = 0; a < 2; ++a)
#pragma unroll
        for (int b = 0; b < 2; ++b)
#pragma unroll
            for (int m = 0; m < 4; ++m)
#pragma unroll
                for (int n = 0; n < 2; ++n) acc[a][b][m][n] = (f32x4){0.f, 0.f, 0.f, 0.f};
    bf16x8 At[4][2], B0[2][2], B1[2][2];
    const char* cA = S.a_base(g, cur); const char* cB = S.b_base(g, cur);
    PG8_SETA(vA, cur);
    if constexpr (GATHER) { asm volatile("s_waitcnt vmcnt(0)" ::: "memory"); asm volatile("" : "+v"(vA[0][0]), "+v"(vA[0][1]), "+v"(vA[1][0]), "+v"(vA[1][1])); }
    if constexpr (SP2) {
        PG8_STAGE(PG8_SB(0, 0), cB, voffB); PG8_STAGE(PG8_SB(0, 1), cB + hstep, voffB); PG8_STAGE(PG8_SA(0, 0), cA, vA[0]); PG8_STAGE(PG8_SA(0, 1), cA, vA[1]);
        if (wr == 1) PG8_BAR;
        PG8_WAIT_V(2); PG8_BAR;
        PG8_STAGE(PG8_SB(1, 0), cB + kstep, voffB); PG8_STAGE(PG8_SA(1, 0), cA + kstep, vA[0]); PG8_STAGE(PG8_SB(1, 1), cB + hstep + kstep, voffB);
        PG8_WAIT_V(6); PG8_BAR;
    } else {
        PG8_STAGE(PG8_SB(0, 0), cB, voffB); PG8_STAGE(PG8_SA(0, 0), cA, vA[0]); PG8_STAGE(PG8_SB(0, 1), cB + hstep, voffB); PG8_STAGE(PG8_SA(0, 1), cA, vA[1]);
        if (wr == 1) PG8_BAR;
        PG8_WAIT_V(4); PG8_BAR;
        PG8_STAGE(PG8_SB(1, 0), cB + kstep, voffB); PG8_STAGE(PG8_SA(1, 0), cA + kstep, vA[0]); PG8_STAGE(PG8_SB(1, 1), cB + hstep + kstep, voffB);
        PG8_WAIT_V(6); PG8_BAR;
    }
    for (;;) {
        const bool has_next = S.next(ui + 1, nxt);
        const char* nA = has_next ? S.a_base(g, nxt) : cA; const char* nB = has_next ? S.b_base(g, nxt) : cB;
        if constexpr (GATHER) {
            if (has_next) { PG8_SETA(vN, nxt); asm volatile("s_waitcnt vmcnt(0)" ::: "memory"); asm volatile("" : "+v"(vN[0][0]), "+v"(vN[0][1]), "+v"(vN[1][0]), "+v"(vN[1][1])); }
            else {
#pragma unroll
                for (int _h = 0; _h < 2; ++_h)
#pragma unroll
                    for (int _i = 0; _i < 2; ++_i) vN[_h][_i] = vA[_h][_i]; }
        }
        for (int t = 0; t < nt; t += 2) {
            const bool last = (t == nt - 2);
            const char* a1 = cA + (size_t)(t + 1) * kstep;
            const char* a2 = last ? nA : cA + (size_t)(t + 2) * kstep; const char* b2 = last ? nB : cB + (size_t)(t + 2) * kstep;
            const char* a3 = a2 + kstep; const char* b3 = b2 + kstep;
            unsigned wA[2][2];
#pragma unroll
            for (int _h = 0; _h < 2; ++_h)
#pragma unroll
                for (int _i = 0; _i < 2; ++_i) wA[_h][_i] = GATHER ? (last ? vN[_h][_i] : vA[_h][_i]) : vA[_h][_i];
            if constexpr (SP2) {
            PG8_LDB(B0, 0, 0); PG8_LDB(B1, 0, 1); PG8_SCHED; PG8_LDA(At, 0, 0); PG8_STAGE(PG8_SA(1, 1), a1, vA[1]);
            PG8_WAIT_V(8); PG8_WAIT_L(0); PG8_BAR; PG8_MMA(0, 0, At, B0); PG8_MMA(0, 1, At, B1); PG8_BAR; PG8_SCHED;
            PG8_LDA(At, 0, 1); PG8_STAGE(PG8_SB(0, 0), b2, voffB); PG8_STAGE(PG8_SB(0, 1), b2 + hstep, voffB); PG8_STAGE(PG8_SA(0, 0), a2, wA[0]);
            PG8_WAIT_V(8); PG8_WAIT_L(0); PG8_BAR; PG8_MMA(1, 0, At, B0); PG8_MMA(1, 1, At, B1); PG8_BAR; PG8_SCHED;
            PG8_LDB(B0, 1, 0); PG8_LDB(B1, 1, 1); PG8_SCHED; PG8_LDA(At, 1, 0); PG8_STAGE(PG8_SA(0, 1), a2, wA[1]);
            PG8_WAIT_V(8); PG8_WAIT_L(0); PG8_BAR; PG8_MMA(0, 0, At, B0); PG8_MMA(0, 1, At, B1); PG8_BAR; PG8_SCHED;
            PG8_LDA(At, 1, 1); PG8_STAGE(PG8_SB(1, 0), b3, voffB); PG8_STAGE(PG8_SB(1, 1), b3 + hstep, voffB); PG8_STAGE(PG8_SA(1, 0), a3, wA[0]);
            PG8_WAIT_V(8); PG8_WAIT_L(0); PG8_BAR; PG8_MMA(1, 0, At, B0); PG8_MMA(1, 1, At, B1); PG8_BAR; PG8_SCHED;
            } else {
            PG8_LDB(B0, 0, 0); PG8_SCHED; PG8_LDA(At, 0, 0); PG8_STAGE(PG8_SA(1, 1), a1, vA[1]);
            PG8_WAIT_L(8); PG8_BAR; PG8_WAIT_L(0); PG8_MMA(0, 0, At, B0); PG8_BAR; PG8_SCHED;
            PG8_LDB(B1, 0, 1); PG8_STAGE(PG8_SB(0, 0), b2, voffB);
            PG8_BAR; PG8_WAIT_L(0); PG8_MMA(0, 1, At, B1); PG8_BAR;
            PG8_LDA(At, 0, 1); PG8_STAGE(PG8_SA(0, 0), a2, wA[0]);
            PG8_BAR; PG8_WAIT_L(0); PG8_MMA(1, 0, At, B0); PG8_BAR; PG8_SCHED;
            PG8_STAGE(PG8_SB(0, 1), b2 + hstep, voffB);
            PG8_WAIT_V(6); PG8_BAR; PG8_MMA(1, 1, At, B1); PG8_BAR;
            PG8_LDB(B0, 1, 0); PG8_SCHED; PG8_LDA(At, 1, 0); PG8_STAGE(PG8_SA(0, 1), a2, wA[1]);
            PG8_WAIT_L(8); PG8_BAR; PG8_WAIT_L(0); PG8_MMA(0, 0, At, B0); PG8_BAR; PG8_SCHED;
            PG8_LDB(B1, 1, 1); PG8_STAGE(PG8_SB(1, 0), b3, voffB);
            PG8_BAR; PG8_WAIT_L(0); PG8_MMA(0, 1, At, B1); PG8_BAR;
            PG8_LDA(At, 1, 1); PG8_STAGE(PG8_SA(1, 0), a3, wA[0]);
            PG8_BAR; PG8_WAIT_L(0); PG8_MMA(1, 0, At, B0); PG8_BAR; PG8_SCHED;
            PG8_STAGE(PG8_SB(1, 1), b3 + hstep, voffB);
            PG8_WAIT_V(6); PG8_BAR; PG8_MMA(1, 1, At, B1); PG8_BAR;
            }
        }
        if constexpr (ALIGN_EPI) { if (wr == 0) PG8_BAR; }
        E(acc, cur, wr, wc, fr, fq);
        if (!has_next) break;
#pragma unroll
        for (int a = 0; a < 2; ++a)
#pragma unroll
            for (int b = 0; b < 2; ++b)
#pragma unroll
                for (int m = 0; m < 4; ++m)
#pragma unroll
                    for (int n = 0; n < 2; ++n) acc[a][b][m][n] = (f32x4){0.f, 0.f, 0.f, 0.f};
        cur = nxt; cA = nA; cB = nB; ++ui;
#pragma unroll
        for (int _h = 0; _h < 2; ++_h)
#pragma unroll
            for (int _i = 0; _i < 2; ++_i) vA[_h][_i] = GATHER ? vN[_h][_i] : vA[_h][_i];
        if constexpr (ALIGN_EPI) { if (wr == 1) PG8_BAR; }
    }
    PG8_WAIT_V(0);
    if constexpr (!ALIGN_EPI) { if (wr == 0) PG8_BAR; }
    PG8_BAR;
#undef PG8_SETA
#undef PG8_SA
#undef PG8_SB
#undef PG8_STAGE
#undef PG8_LDA
#undef PG8_LDB
#undef PG8_MMA
#undef PG8_WAIT_V
#undef PG8_WAIT_L
#undef PG8_BAR
#undef PG8_SCHED
}
}

constexpr int NWAVES = 8;
constexpr int M = 16384, D = 1024, AW = 512, NH = 8, HD = 64, CCH = 512, CWID = 31, NE = 32, DE = 1024, PLE = 256;
constexpr int IN_COLS = 5192, NPROJ = 5376;
constexpr float LN_EPS = 1e-5f;
constexpr float ALPHA = 1.18920711500272f;
constexpr float LOG2E = 1.4426950408889634f;
constexpr float C2 = 0.125f * LOG2E;
constexpr int RMAX = 73728;
constexpr int TOPK = 256;

constexpr size_t MiB = 1u << 20;
constexpr size_t WS_CTL = 0, CTL_ZERO_BYTES = 1 * MiB;
constexpr size_t WS_SMALL = 1 * MiB;
constexpr size_t WS_BIASP = WS_SMALL;
constexpr size_t WS_BGUP = WS_SMALL + 32 * 1024;
constexpr size_t WS_RT = WS_SMALL + 320 * 1024;
constexpr size_t WS_EXPOFF = WS_SMALL + 328 * 1024;
constexpr size_t WS_CNTCH = WS_SMALL + 332 * 1024;
constexpr size_t WS_WIN = 2 * MiB;
constexpr size_t WS_WOA = 13 * MiB, WS_WOC = 14 * MiB, WS_WOUT = 15 * MiB, WS_WPG = 17 * MiB, WS_WPP = 19 * MiB;
constexpr size_t WS_WGU = 20 * MiB;
constexpr size_t WS_WD = 148 * MiB;
constexpr size_t WS_XB = 212 * MiB;
constexpr size_t WS_Q = 252 * MiB, WS_K = 268 * MiB, WS_V = 284 * MiB, WS_QI = 300 * MiB;
constexpr size_t WS_KI = 316 * MiB;
constexpr size_t WS_WI = 318 * MiB;
constexpr size_t WS_U = 319 * MiB;
constexpr size_t WS_SG = 335 * MiB;
constexpr size_t WS_MASK = 399 * MiB;
constexpr size_t WS_AO = 431 * MiB, WS_CO = 447 * MiB;
constexpr size_t WS_T = 463 * MiB, WS_MG = 495 * MiB;
constexpr size_t WS_H1 = 527 * MiB;
constexpr size_t WS_X1 = 591 * MiB;
constexpr size_t WS_X1B = 655 * MiB;
constexpr size_t WS_ROUTE = 687 * MiB;
constexpr size_t WS_TOPI = WS_ROUTE, WS_TOPG = WS_ROUTE + 256 * 1024, WS_TOKPOS = WS_ROUTE + 512 * 1024, WS_ROWTOK = WS_ROUTE + 768 * 1024, WS_ROWGATE = WS_ROUTE + 1088 * 1024;
constexpr size_t WS_PP = 689 * MiB;
constexpr size_t WS_PB = 721 * MiB;
constexpr size_t WS_END = 729 * MiB;
constexpr size_t WS_HB = 212 * MiB;
constexpr size_t WS_Y = 356 * MiB;
constexpr size_t WS_HH = WS_H1;
constexpr size_t WS_HHB = WS_X1B;
constexpr size_t WS_V2 = WS_X1;
static_assert(WS_HB + (size_t)RMAX * 1024 * 2 <= WS_Y && WS_Y + (size_t)RMAX * 1024 * 2 <= WS_H1, "overlay map");
static_assert(WS_ROWGATE + RMAX * 4 <= WS_PP, "route map");

constexpr int CW_TMO = 0;
constexpr int CW_BAR = 4096;

constexpr int RING_OFF = 0, RING_BYTES = 131072;
constexpr int LDSCTL_OFF = RING_BYTES, MISC_OFF = LDSCTL_OFF + 320;
constexpr int LDS_BYTES = 147456;
static_assert(MISC_OFF + 128 <= LDS_BYTES, "LDS map");

#define GAS __attribute__((address_space(1)))
#define LAS __attribute__((address_space(3)))
typedef unsigned short bf16;
typedef unsigned v4u __attribute__((ext_vector_type(4)));
typedef unsigned v2u __attribute__((ext_vector_type(2)));
typedef float f32x4 __attribute__((ext_vector_type(4)));
typedef float f32x16 __attribute__((ext_vector_type(16)));
typedef short bf16x8 __attribute__((ext_vector_type(8)));
typedef GAS unsigned gu32;
typedef GAS unsigned long long gu64;
#define RLX_AGENT __ATOMIC_RELAXED, __HIP_MEMORY_SCOPE_AGENT
#define LDS_WAIT() asm volatile("s_waitcnt lgkmcnt(0)" ::: "memory")
#define VM_WAIT() asm volatile("s_waitcnt vmcnt(0)" ::: "memory")
__device__ __forceinline__ unsigned f2bf(float f) { unsigned u = __builtin_bit_cast(unsigned, f); return (u + 0x7fffu + ((u >> 16) & 1u)) >> 16; }
__device__ __forceinline__ float bf2f(unsigned b) { return __builtin_bit_cast(float, b << 16); }
__device__ __forceinline__ float bflo(unsigned w) { return __builtin_bit_cast(float, w << 16); }
__device__ __forceinline__ float bfhi(unsigned w) { return __builtin_bit_cast(float, w & 0xffff0000u); }
__device__ __forceinline__ float sigmoidf_(float x) { return __builtin_amdgcn_rcpf(1.0f + __builtin_amdgcn_exp2f(-LOG2E * x)); }
__device__ __forceinline__ LAS unsigned char* lds_opaque(LAS unsigned char* p) { unsigned a = (unsigned)(unsigned long)p; asm volatile("" : "+v"(a)); return (LAS unsigned char*)(unsigned long)a; }
__device__ __forceinline__ unsigned pk2(float lo, float hi) { return f2bf(lo) | (f2bf(hi) << 16); }

#define XB_TMO      128
#define XB_XCNT(j)  (256  + 64 * (j))
#define XB_XSUB(j)  (1280 + 64 * (j))
#define XB_XGEN(j)  (2304 + 64 * (j))
#define XB_TOP      3328
#define XB_TOPGEN   3392
#define XCD_BAR_WORDS 3456
#define XB_SPIN_CAP (1u << 18)

__device__ __forceinline__ unsigned xb_ld(unsigned* p)              { return __hip_atomic_load(p, __ATOMIC_RELAXED, __HIP_MEMORY_SCOPE_AGENT); }
__device__ __forceinline__ unsigned xb_add(unsigned* p, unsigned v) { return __hip_atomic_fetch_add(p, v, __ATOMIC_RELAXED, __HIP_MEMORY_SCOPE_AGENT); }
__device__ __forceinline__ unsigned xb_xcc_id() { return (unsigned)__builtin_amdgcn_s_getreg((3 << 11) | 20) & 0xFu; }
#define XB_SPIN(cond, bar) do { unsigned _sp = 0; while (cond) { __builtin_amdgcn_s_sleep(1); \
    if ((++_sp & 255u) == 0u) { if (xb_ld(&(bar)[XB_TMO])) break; if (_sp > XB_SPIN_CAP) { atomicAdd(&(bar)[XB_TMO], 1u); break; } } } } while (0)

struct XcdBarrier {
    unsigned* bar; unsigned x;
    volatile LAS unsigned* st;
};

__device__ __forceinline__ XcdBarrier xcd_barrier_post(unsigned* bar, volatile LAS unsigned* st) {
    XcdBarrier b; b.bar = bar; b.x = xb_xcc_id(); b.st = st;
    if (threadIdx.x == 0) (void)xb_add(&bar[XB_XCNT(b.x)], 1u);
    return b;
}
__device__ __forceinline__ void xcd_barrier_complete(unsigned* bar, unsigned x, unsigned& nloc, unsigned& nx) {
    const unsigned G = gridDim.x * gridDim.y * gridDim.z;
    unsigned sum, cnt, mine, sp = 0u;
    for (;;) {
        sum = 0u; cnt = 0u; mine = 0u;
#pragma unroll
        for (unsigned j = 0; j < 16; ++j) { const unsigned c = xb_ld(&bar[XB_XCNT(j)]); sum += c; cnt += (c > 0u) ? 1u : 0u; mine = (j == x) ? c : mine; }
        if (sum == G) break;
        __builtin_amdgcn_s_sleep(1);
        if ((++sp & 255u) == 0u) { if (xb_ld(&bar[XB_TMO])) break; if (sp > XB_SPIN_CAP) { atomicAdd(&bar[XB_TMO], 1u); break; } }
    }
    nloc = mine > 0u ? mine : 1u; nx = cnt > 0u ? cnt : 1u;
}

__device__ __forceinline__ void xcd_barrier(const XcdBarrier& b) {
    asm volatile("s_waitcnt vmcnt(0)" ::: "memory");
    __syncthreads();
    if (threadIdx.x == 0) {
        unsigned* bar = b.bar;
        __builtin_amdgcn_s_waitcnt(0);
        unsigned nloc = b.st[0], nx = b.st[1];
        if (nloc == 0u) { xcd_barrier_complete(bar, b.x, nloc, nx); b.st[0] = nloc; b.st[1] = nx; }
        const unsigned old = xb_add(&bar[XB_XSUB(b.x)], 1u);
        const unsigned gen = old / nloc;
        if (old + 1u == (gen + 1u) * nloc) {
            __builtin_amdgcn_fence(__ATOMIC_RELEASE, "agent");
            asm volatile("s_waitcnt vmcnt(0)" ::: "memory");
            const unsigned og = xb_add(&bar[XB_TOP], 1u);
            const unsigned tg = og / nx;
            if (og + 1u == (tg + 1u) * nx) xb_add(&bar[XB_TOPGEN], 1u);
            else XB_SPIN(xb_ld(&bar[XB_TOPGEN]) == tg, bar);
            __builtin_amdgcn_fence(__ATOMIC_ACQUIRE, "agent");
            xb_add(&bar[XB_XGEN(b.x)], 1u);
            asm volatile("s_waitcnt vmcnt(0)" ::: "memory");
        } else {
            XB_SPIN(xb_ld(&bar[XB_XGEN(b.x)]) == gen, bar);
            __builtin_amdgcn_fence(__ATOMIC_ACQUIRE, "agent");
            asm volatile("s_waitcnt vmcnt(0)" ::: "memory");
        }
    }
    __syncthreads();
}


__device__ __forceinline__ float wave_sum(float v) {
#pragma unroll
    for (int o = 1; o < 64; o <<= 1) v += __shfl_xor(v, o);
    return v;
}
__device__ __forceinline__ unsigned f2key(float f) { const unsigned u = __builtin_bit_cast(unsigned, f); return (u & 0x80000000u) ? ~u : (u | 0x80000000u); }
__device__ __forceinline__ int map_in(int n) {
    if (n < 2048) return n;
    if (n < 2112) return 5120 + (n - 2048);
    if (n < 2120) return 5184 + (n - 2112);
    if (n < 2632) { const int c = n - 2120; return 2048 + 8 * (c >> 2) + (c & 3); }
    if (n < 3144) { const int c = n - 2632; return 2048 + 8 * (c >> 2) + 4 + (c & 3); }
    return 3072 + (n - 3144);
}
__device__ __forceinline__ int map_gu(int n) { const int c = n & 1023; return 8 * (c >> 2) + ((n >> 10) << 2) + (c & 3); }
__device__ __forceinline__ int map_id(int n) { return n; }

template <class MapF>
__device__ __forceinline__ void transpose_item(const float* W, int K, int N, bf16* WT, LAS float* scr, int item, int lane, MapF map) {
    const int nblk = (N + 31) / 32, kb = item / nblk, nb = item % nblk, k0 = 64 * kb, n0 = 32 * nb;
    const int nn = n0 + (lane & 31);
#pragma unroll 8
    for (int i = 0; i < 32; ++i) { const int kk = 2 * i + (lane >> 5); scr[kk * 33 + (lane & 31)] = nn < N ? W[(size_t)(k0 + kk) * N + nn] : 0.f; }
    LDS_WAIT(); asm volatile("" ::: "memory");
    const int c = lane & 7;
#pragma unroll
    for (int j = 0; j < 4; ++j) { const int nl = (lane >> 3) + 8 * j; const LAS float* s = scr + (8 * c) * 33 + nl;
        v4u o; o.x = pk2(s[0 * 33], s[1 * 33]); o.y = pk2(s[2 * 33], s[3 * 33]); o.z = pk2(s[4 * 33], s[5 * 33]); o.w = pk2(s[6 * 33], s[7 * 33]);
        if (n0 + nl < N) *(GAS v4u*)(WT + (size_t)map(n0 + nl) * K + k0 + 8 * c) = o; }
    LDS_WAIT(); asm volatile("" ::: "memory");
}

struct Ptrs {
    const float *x, *p, *w_in, *b_in, *w_o_attn, *w_dw, *b_dw, *conv_ln_g, *conv_ln_b, *w_o_conv, *w_out, *ln1_g, *ln1_b, *w_router, *b_router, *w_gate_up, *b_gate_up, *w_down, *b_down,
        *w_ple_gate, *w_ple_proj, *ln2_g, *ln2_b, *rel_bias;
    float* out; unsigned char* ws;
};

__device__ __forceinline__ void ph_prologue(const Ptrs& P, LAS unsigned char* lds, int G) {
    const int tid = threadIdx.x, lane = tid & 63, wave = __builtin_amdgcn_readfirstlane(tid >> 6);
    unsigned char* ws = P.ws;
    LAS float* scr = (LAS float*)(lds + RING_OFF + wave * 16384);
    const int gw = blockIdx.x * NWAVES + wave, NGW = G * NWAVES;
    constexpr int I_IN = 16 * 163, I_OA = 8 * 32, I_OC = 8 * 32, I_OUT = 16 * 32, I_PG = 16 * 32, I_PP = 4 * 32, I_GU1 = 16 * 64, I_D1 = 16 * 32;
    constexpr int NITEMS = I_IN + I_OA + I_OC + I_OUT + I_PG + I_PP + NE * I_GU1 + NE * I_D1;
    for (int it = gw; it < NITEMS; it += NGW) {
        int r = it;
        if (r < I_IN) { transpose_item(P.w_in, D, IN_COLS, (bf16*)(ws + WS_WIN), scr, r, lane, map_in); continue; } r -= I_IN;
        if (r < I_OA) { transpose_item(P.w_o_attn, AW, D, (bf16*)(ws + WS_WOA), scr, r, lane, map_id); continue; } r -= I_OA;
        if (r < I_OC) { transpose_item(P.w_o_conv, CCH, D, (bf16*)(ws + WS_WOC), scr, r, lane, map_id); continue; } r -= I_OC;
        if (r < I_OUT) { transpose_item(P.w_out, D, D, (bf16*)(ws + WS_WOUT), scr, r, lane, map_id); continue; } r -= I_OUT;
        if (r < I_PG) { transpose_item(P.w_ple_gate, D, D, (bf16*)(ws + WS_WPG), scr, r, lane, map_id); continue; } r -= I_PG;
        if (r < I_PP) { transpose_item(P.w_ple_proj, PLE, D, (bf16*)(ws + WS_WPP), scr, r, lane, map_id); continue; } r -= I_PP;
        if (r < NE * I_GU1) { const int e = r / I_GU1; transpose_item(P.w_gate_up + (size_t)e * D * 2 * DE, D, 2 * DE, (bf16*)(ws + WS_WGU) + (size_t)e * 2 * DE * D, scr, r % I_GU1, lane, map_gu); continue; } r -= NE * I_GU1;
        { const int e = r / I_D1; transpose_item(P.w_down + (size_t)e * DE * D, DE, D, (bf16*)(ws + WS_WD) + (size_t)e * D * DE, scr, r % I_D1, lane, map_id); }
    }
    const size_t gt = (size_t)blockIdx.x * (NWAVES * 64) + tid, NT = (size_t)G * NWAVES * 64;
    for (size_t i = gt; i < (size_t)M * D / 8; i += NT) { const f32x4 a = ((const GAS f32x4*)P.x)[2 * i], b = ((const GAS f32x4*)P.x)[2 * i + 1];
        v4u o; o.x = pk2(a.x, a.y); o.y = pk2(a.z, a.w); o.z = pk2(b.x, b.y); o.w = pk2(b.z, b.w); ((GAS v4u*)(ws + WS_XB))[i] = o; }
    for (size_t i = gt; i < (size_t)M * PLE / 8; i += NT) { const f32x4 a = ((const GAS f32x4*)P.p)[2 * i], b = ((const GAS f32x4*)P.p)[2 * i + 1];
        v4u o; o.x = pk2(a.x, a.y); o.y = pk2(a.z, a.w); o.z = pk2(b.x, b.y); o.w = pk2(b.z, b.w); ((GAS v4u*)(ws + WS_PB))[i] = o; }
    float* biasp = (float*)(ws + WS_BIASP); float* bgup = (float*)(ws + WS_BGUP); float* rt = (float*)(ws + WS_RT);
    for (size_t i = gt; i < (size_t)IN_COLS; i += NT) biasp[map_in((int)i)] = P.b_in[i];
    for (size_t i = gt; i < (size_t)NE * 2 * DE; i += NT) { const int e = (int)(i >> 11), n = (int)(i & 2047); bgup[e * 2048 + map_gu(n)] = P.b_gate_up[i]; }
    for (size_t i = gt; i < (size_t)NH * 128; i += NT) { const int h = (int)(i >> 7), rel = (int)(i & 127);
        int bkt; if (rel < 16) bkt = rel; else { bkt = 16 + (int)(logf((float)rel * (1.0f / 16.0f)) / logf(8.0f) * 16.0f); bkt = bkt > 31 ? 31 : bkt; }
        rt[h * 128 + rel] = P.rel_bias[bkt * NH + h] * LOG2E; }
}

using pg8::Unit; using pg8::cvt_pk_bf16; using pg8::HALF; using pg8::BM;
__device__ __forceinline__ v4u pack8(const f32x4& a, const f32x4& b) { v4u w; w.x = cvt_pk_bf16(a[0], a[1]); w.y = cvt_pk_bf16(a[2], a[3]); w.z = cvt_pk_bf16(b[0], b[1]); w.w = cvt_pk_bf16(b[2], b[3]); return w; }
__device__ __forceinline__ f32x4 sig4(const f32x4& a) { f32x4 r; r[0] = sigmoidf_(a[0]); r[1] = sigmoidf_(a[1]); r[2] = sigmoidf_(a[2]); r[3] = sigmoidf_(a[3]); return r; }
__device__ __forceinline__ void unpack8(const v4u w, f32x4& a, f32x4& b) { a[0] = bflo(w.x); a[1] = bfhi(w.x); a[2] = bflo(w.y); a[3] = bfhi(w.y); b[0] = bflo(w.z); b[1] = bfhi(w.z); b[2] = bflo(w.w); b[3] = bfhi(w.w); }

struct EpiProj {
    static constexpr bool PERM = true;
    unsigned char* ws; const float* biasp;
    __device__ __forceinline__ void operator()(const f32x4 (&acc)[2][2][4][2], const Unit& u, int wr, int wc, int fr, int fq) const {
        const int row0 = u.pm * BM + wr * 64 + fr, cl0 = wc * 32 + 8 * fq, pn = u.pn;
        f32x4 bv[2][2];
#pragma unroll
        for (int bj = 0; bj < 2; ++bj)
#pragma unroll
            for (int n = 0; n < 2; ++n) bv[bj][n] = *(const f32x4*)(biasp + pn * BM + cl0 + bj * HALF + 4 * n);
#pragma unroll
        for (int ai = 0; ai < 2; ++ai)
#pragma unroll
            for (int m = 0; m < 4; ++m) { const size_t row = (size_t)(row0 + ai * HALF + m * 16);
#pragma unroll
                for (int bj = 0; bj < 2; ++bj) { f32x4 v0 = acc[ai][bj][m][0] + bv[bj][0], v1 = acc[ai][bj][m][1] + bv[bj][1]; const int cl = cl0 + bj * HALF;
                    if (pn < 8) { const int t = pn >> 1; if (t == 0) { v0 = v0 * C2; v1 = v1 * C2; }
                        bf16* base = (bf16*)(ws + WS_Q + (size_t)t * (WS_K - WS_Q)); *(v4u*)(base + row * 512 + (pn & 1) * 256 + cl) = pack8(v0, v1); }
                    else if (pn < 12) { const f32x4 s = sig4(v1); v2u w; w.x = cvt_pk_bf16(v0[0] * s[0], v0[1] * s[1]); w.y = cvt_pk_bf16(v0[2] * s[2], v0[3] * s[3]);
                        *(v2u*)((bf16*)(ws + WS_U) + row * 512 + (pn - 8) * 128 + (cl >> 1)) = w; }
                    else if (pn < 20) { *(v4u*)((bf16*)(ws + WS_SG) + row * 2048 + (pn - 12) * 256 + cl) = pack8(sig4(v0), sig4(v1)); }
                    else { if (cl < 64) *(v4u*)((bf16*)(ws + WS_KI) + row * 64 + cl) = pack8(v0, v1);
                           else if (cl == 64) { float* wi = (float*)(ws + WS_WI) + row * 8; *(f32x4*)wi = v0; *(f32x4*)(wi + 4) = v1; } }
                } }
    }
};
template <bool ADD> struct EpiGated {
    static constexpr bool PERM = true;
    const bf16* G; int goff; const bf16* T; bf16* O;
    __device__ __forceinline__ void operator()(const f32x4 (&acc)[2][2][4][2], const Unit& u, int wr, int wc, int fr, int fq) const {
        const int row0 = u.pm * BM + wr * 64 + fr, col0 = u.pn * BM + wc * 32 + 8 * fq;
#pragma unroll
        for (int ai = 0; ai < 2; ++ai)
#pragma unroll
            for (int m = 0; m < 4; ++m) { const size_t row = (size_t)(row0 + ai * HALF + m * 16);
#pragma unroll
                for (int bj = 0; bj < 2; ++bj) { const int col = col0 + bj * HALF; f32x4 g0, g1; unpack8(*(const v4u*)(G + row * 2048 + goff + col), g0, g1);
                    f32x4 v0 = acc[ai][bj][m][0] * g0, v1 = acc[ai][bj][m][1] * g1;
                    if (ADD) { f32x4 t0, t1; unpack8(*(const v4u*)(T + row * 1024 + col), t0, t1); v0 = v0 + t0; v1 = v1 + t1; }
                    *(v4u*)(O + row * 1024 + col) = pack8(v0, v1); } }
    }
};
struct EpiRes {
    static constexpr bool PERM = false;
    const float* X; float* O;
    __device__ __forceinline__ void operator()(const f32x4 (&acc)[2][2][4][2], const Unit& u, int wr, int wc, int fr, int fq) const {
        const int row0 = u.pm * BM + wr * 64 + fr, col0 = u.pn * BM + wc * 32 + 4 * fq;
#pragma unroll
        for (int ai = 0; ai < 2; ++ai)
#pragma unroll
            for (int m = 0; m < 4; ++m) { const size_t off = (size_t)(row0 + ai * HALF + m * 16) * D + col0;
#pragma unroll
                for (int bj = 0; bj < 2; ++bj)
#pragma unroll
                    for (int n = 0; n < 2; ++n) { const f32x4 xv = *(const f32x4*)(X + off + bj * HALF + n * 16); *(f32x4*)(O + off + bj * HALF + n * 16) = xv * ALPHA + acc[ai][bj][m][n]; }
                asm volatile("" ::: "memory"); }
    }
};
struct EpiSwiglu {
    static constexpr bool PERM = true;
    const float* bgup; bf16* HB;
    __device__ __forceinline__ void operator()(const f32x4 (&acc)[2][2][4][2], const Unit& u, int wr, int wc, int fr, int fq) const {
        const int row0 = u.pm * BM + wr * 64 + fr, cl0 = u.pn * BM + wc * 32 + 8 * fq;
        f32x4 bv[2][2];
#pragma unroll
        for (int bj = 0; bj < 2; ++bj)
#pragma unroll
            for (int n = 0; n < 2; ++n) bv[bj][n] = *(const f32x4*)(bgup + u.e * 2048 + cl0 + bj * HALF + 4 * n);
#pragma unroll
        for (int ai = 0; ai < 2; ++ai)
#pragma unroll
            for (int m = 0; m < 4; ++m) { const size_t row = (size_t)(row0 + ai * HALF + m * 16);
#pragma unroll
                for (int bj = 0; bj < 2; ++bj) { const f32x4 g = acc[ai][bj][m][0] + bv[bj][0], uu = acc[ai][bj][m][1] + bv[bj][1]; float a[4];
#pragma unroll
                    for (int j = 0; j < 4; ++j) { const float gg = fminf(g[j], 7.0f), uc = fminf(fmaxf(uu[j], -7.0f), 7.0f); a[j] = (uc + 1.0f) * gg * sigmoidf_(1.702f * gg); }
                    v2u w; w.x = cvt_pk_bf16(a[0], a[1]); w.y = cvt_pk_bf16(a[2], a[3]);
                    *(v2u*)(HB + row * 1024 + ((cl0 + bj * HALF) >> 1)) = w; } }
    }
};
struct EpiDown {
    static constexpr bool PERM = true;
    const float* bd; const float* rowgate; bf16* Y;
    __device__ __forceinline__ void operator()(const f32x4 (&acc)[2][2][4][2], const Unit& u, int wr, int wc, int fr, int fq) const {
        const int row0 = u.pm * BM + wr * 64 + fr, col0 = u.pn * BM + wc * 32 + 8 * fq;
        f32x4 bv[2][2];
#pragma unroll
        for (int bj = 0; bj < 2; ++bj)
#pragma unroll
            for (int n = 0; n < 2; ++n) bv[bj][n] = *(const f32x4*)(bd + u.e * 1024 + col0 + bj * HALF + 4 * n);
#pragma unroll
        for (int ai = 0; ai < 2; ++ai)
#pragma unroll
            for (int m = 0; m < 4; ++m) { const size_t row = (size_t)(row0 + ai * HALF + m * 16); const float gt = rowgate[row];
#pragma unroll
                for (int bj = 0; bj < 2; ++bj) *(v4u*)(Y + row * 1024 + col0 + bj * HALF) = pack8((acc[ai][bj][m][0] + bv[bj][0]) * gt, (acc[ai][bj][m][1] + bv[bj][1]) * gt); }
    }
};
struct EpiPlain {
    static constexpr bool PERM = true;
    bf16* O;
    __device__ __forceinline__ void operator()(const f32x4 (&acc)[2][2][4][2], const Unit& u, int wr, int wc, int fr, int fq) const {
        const int row0 = u.pm * BM + wr * 64 + fr, col0 = u.pn * BM + wc * 32 + 8 * fq;
#pragma unroll
        for (int ai = 0; ai < 2; ++ai)
#pragma unroll
            for (int m = 0; m < 4; ++m) { const size_t row = (size_t)(row0 + ai * HALF + m * 16);
#pragma unroll
                for (int bj = 0; bj < 2; ++bj) *(v4u*)(O + row * 1024 + col0 + bj * HALF) = pack8(acc[ai][bj][m][0], acc[ai][bj][m][1]); }
    }
};
struct EpiPle {
    static constexpr bool PERM = false;
    const float* HH; const bf16* PP; float* O;
    __device__ __forceinline__ void operator()(const f32x4 (&acc)[2][2][4][2], const Unit& u, int wr, int wc, int fr, int fq) const {
        const int row0 = u.pm * BM + wr * 64 + fr, col0 = u.pn * BM + wc * 32 + 4 * fq;
#pragma unroll
        for (int ai = 0; ai < 2; ++ai)
#pragma unroll
            for (int m = 0; m < 4; ++m) { const size_t off = (size_t)(row0 + ai * HALF + m * 16) * D + col0;
#pragma unroll
                for (int bj = 0; bj < 2; ++bj)
#pragma unroll
                    for (int n = 0; n < 2; ++n) { const size_t o = off + bj * HALF + n * 16; const f32x4 hv = *(const f32x4*)(HH + o); const v2u pw = *(const v2u*)(PP + o);
                        f32x4 pp; pp[0] = bflo(pw.x); pp[1] = bfhi(pw.x); pp[2] = bflo(pw.y); pp[3] = bfhi(pw.y);
                        *(f32x4*)(O + o) = hv + sig4(acc[ai][bj][m][n]) * pp; }
                asm volatile("" ::: "memory"); }
    }
};

template <bool GATH> struct MoeOrder {
    static constexpr bool GATHER = GATH;
    const LAS int* off; int NT, G, c; const int* rowtok; int K; size_t bstride;
    __device__ __forceinline__ bool next(int i, Unit& u) const {
        int L = i * G + c, cum = 0;
        for (int e = 0; e < NE; ++e) { const int tiles = (off[e + 1] - off[e]) >> 8, nu = tiles * NT;
            if (L < cum + nu) { const int loc = L - cum; u.e = e; u.pm = (off[e] >> 8) + loc % tiles; u.pn = loc / tiles; return true; }
            cum += nu; }
        return false;
    }
    __device__ __forceinline__ const char* a_base(const pg8::Gemm& g, const Unit& u) const { return GATH ? (const char*)g.A : (const char*)g.A + (size_t)u.pm * ((size_t)BM * g.K * 2); }
    __device__ __forceinline__ const char* b_base(const pg8::Gemm& g, const Unit& u) const { return (const char*)g.Bt + (size_t)u.e * bstride + (size_t)u.pn * ((size_t)BM * g.K * 2); }
    __device__ __forceinline__ unsigned a_rowoff(const Unit& u, int h, int R) const { return (unsigned)rowtok[u.pm * BM + h * HALF + R] * (unsigned)(K * 2); }
};

__device__ __forceinline__ void ph_conv(const Ptrs& P, LAS unsigned char* lds, int G) {
    const int tid = threadIdx.x, lane = tid & 63, wave = __builtin_amdgcn_readfirstlane(tid >> 6);
    const bf16* U = (const bf16*)(P.ws + WS_U); bf16* CO = (bf16*)(P.ws + WS_CO);
    LAS bf16* ul = (LAS bf16*)(lds);
    LAS float* yl = (LAS float*)(lds + 65536);
    float w[CWID];
#pragma unroll
    for (int j = 0; j < CWID; ++j) w[j] = P.w_dw[j * CCH + tid];
    const float bdw = P.b_dw[tid];
    f32x4 lg[2], lb[2];
    lg[0] = *(const f32x4*)(P.conv_ln_g + 8 * lane); lg[1] = *(const f32x4*)(P.conv_ln_g + 8 * lane + 4);
    lb[0] = *(const f32x4*)(P.conv_ln_b + 8 * lane); lb[1] = *(const f32x4*)(P.conv_ln_b + 8 * lane + 4);
    for (int ch = blockIdx.x; ch < M / 32; ch += G) {
        const int t0 = ch * 32;
        for (int i = tid; i < 62 * 64; i += 512) { const int r = i >> 6, c8 = i & 63; const int t = t0 - 30 + r;
            v4u v = (v4u){0u, 0u, 0u, 0u}; if (t >= 0) v = *(const GAS v4u*)(U + (size_t)t * CCH + c8 * 8);
            *(LAS v4u*)(ul + r * CCH + c8 * 8) = v; }
        __syncthreads();
        float uu[62];
#pragma unroll
        for (int r = 0; r < 62; ++r) uu[r] = bf2f(ul[r * CCH + tid]);
        float acc[32];
#pragma unroll
        for (int i = 0; i < 32; ++i) { float a = bdw;
#pragma unroll
            for (int j = 0; j < CWID; ++j) a += w[j] * uu[i + j];
            acc[i] = a; }
#pragma unroll
        for (int i = 0; i < 32; ++i) yl[i * CCH + tid] = acc[i];
        __syncthreads();
#pragma unroll
        for (int q = 0; q < 4; ++q) { const int tt = wave + 8 * q;
            f32x4 a = *(const LAS f32x4*)(yl + tt * CCH + 8 * lane), b = *(const LAS f32x4*)(yl + tt * CCH + 8 * lane + 4);
            const float mean = wave_sum((a[0] + a[1]) + (a[2] + a[3]) + (b[0] + b[1]) + (b[2] + b[3])) * (1.0f / CCH);
            a = a - mean; b = b - mean;
            const float var = wave_sum((a[0] * a[0] + a[1] * a[1]) + (a[2] * a[2] + a[3] * a[3]) + (b[0] * b[0] + b[1] * b[1]) + (b[2] * b[2] + b[3] * b[3])) * (1.0f / CCH);
            const float rstd = 1.0f / sqrtf(var + LN_EPS);
            a = a * rstd * lg[0] + lb[0]; b = b * rstd * lg[1] + lb[1];
            a = a * sig4(a); b = b * sig4(b);
            *(GAS v4u*)(CO + (size_t)(t0 + tt) * CCH + 8 * lane) = pack8(a, b); }
        __syncthreads();
    }
}

__device__ __forceinline__ void ph_index_slow(const Ptrs& P, LAS unsigned char* lds, int G) {
    const int tid = threadIdx.x, lane = tid & 63, wave = __builtin_amdgcn_readfirstlane(tid >> 6);
    const bf16* QI = (const bf16*)(P.ws + WS_QI); const bf16* KI = (const bf16*)(P.ws + WS_KI); const float* WI = (const float*)(P.ws + WS_WI);
    unsigned* MASK = (unsigned*)(P.ws + WS_MASK);
    LAS float* sc = (LAS float*)lds;
    LAS float* qs = (LAS float*)lds_opaque(lds + 65536);
    LAS unsigned* hist = (LAS unsigned*)(lds + 65536 + 2048);
    LAS unsigned* ctl = hist + 256;
    LAS float* wsm = (LAS float*)(ctl + 8);
    for (int t = blockIdx.x; t < M; t += G) {
        qs[tid] = bf2f(QI[(size_t)t * 512 + tid]); if (tid < 8) wsm[tid] = WI[(size_t)t * 8 + tid];
        __syncthreads();
        const int n = t + 1;
        for (int s = tid; s < n; s += 512) {
            asm volatile("" ::: "memory");
            float d[8];
#pragma unroll
            for (int h = 0; h < 8; ++h) d[h] = 0.f;
#pragma unroll
            for (int c = 0; c < 8; ++c) { const v4u v = *(const GAS v4u*)(KI + (size_t)s * 64 + c * 8);
                const float k0 = bflo(v.x), k1 = bfhi(v.x), k2 = bflo(v.y), k3 = bfhi(v.y), k4 = bflo(v.z), k5 = bfhi(v.z), k6 = bflo(v.w), k7 = bfhi(v.w);
#pragma unroll
                for (int h = 0; h < 8; ++h) { const f32x4 qa = *(const LAS f32x4*)(qs + h * 64 + c * 8), qb = *(const LAS f32x4*)(qs + h * 64 + c * 8 + 4);
                    d[h] += (qa[0] * k0 + qa[1] * k1) + (qa[2] * k2 + qa[3] * k3) + (qb[0] * k4 + qb[1] * k5) + (qb[2] * k6 + qb[3] * k7); }
                __builtin_amdgcn_sched_barrier(0); }
            float score = 0.f;
#pragma unroll
            for (int h = 0; h < 8; ++h) score += wsm[h] * fmaxf(d[h], 0.f);
            sc[s] = score;
        }
        __syncthreads();
        unsigned tkey = 0u;
        if (n > TOPK) {
            unsigned prefix = 0u; int krem = TOPK;
            for (int shift = 24; shift >= 0; shift -= 8) {
                if (tid < 256) hist[tid] = 0u;
                __syncthreads();
                for (int s = tid; s < n; s += 512) { const unsigned key = f2key(sc[s]); const bool match = (shift == 24) ? true : ((key >> (shift + 8)) == (prefix >> (shift + 8)));
                    if (match) atomicAdd((unsigned*)&hist[(key >> shift) & 255u], 1u); }
                __syncthreads();
                if (wave == 0) {
                    unsigned c0 = hist[4 * lane], c1 = hist[4 * lane + 1], c2 = hist[4 * lane + 2], c3 = hist[4 * lane + 3];
                    const unsigned tot = c0 + c1 + c2 + c3; unsigned suf = tot;
#pragma unroll
                    for (int o = 1; o < 64; o <<= 1) { const unsigned v = __shfl_down(suf, o); if (lane + o < 64) suf += v; }
                    const unsigned above = suf - tot;
                    if (suf >= (unsigned)krem && above < (unsigned)krem) {
                        unsigned cum = above; int digit; unsigned newk;
                        if (cum + c3 >= (unsigned)krem) { digit = 4 * lane + 3; newk = krem - cum; }
                        else { cum += c3; if (cum + c2 >= (unsigned)krem) { digit = 4 * lane + 2; newk = krem - cum; }
                            else { cum += c2; if (cum + c1 >= (unsigned)krem) { digit = 4 * lane + 1; newk = krem - cum; } else { cum += c1; digit = 4 * lane; newk = krem - cum; } } }
                        ctl[0] = prefix | ((unsigned)digit << shift); ctl[1] = newk;
                    }
                }
                __syncthreads();
                prefix = ctl[0]; krem = (int)ctl[1];
            }
            tkey = prefix;
        }
        for (int c = wave; c < 256; c += 8) { const int s = 64 * c + lane; const bool bit = (s < n) && (f2key(sc[s < n ? s : 0]) >= tkey);
            const unsigned long long m = __ballot(bit);
            if (lane == 0) { MASK[(size_t)t * 512 + 2 * c] = (unsigned)m; MASK[(size_t)t * 512 + 2 * c + 1] = (unsigned)(m >> 32); } }
        __syncthreads();
    }
}

__device__ __forceinline__ void ph_attn_slow(const Ptrs& P, int G) {
    const int tid = threadIdx.x, lane = tid & 63, wave = __builtin_amdgcn_readfirstlane(tid >> 6);
    const bf16* Q = (const bf16*)(P.ws + WS_Q); const bf16* K = (const bf16*)(P.ws + WS_K); const bf16* V = (const bf16*)(P.ws + WS_V);
    const unsigned* MASK = (const unsigned*)(P.ws + WS_MASK); const float* RT = (const float*)(P.ws + WS_RT); bf16* AO = (bf16*)(P.ws + WS_AO);
    const int head = lane >> 3, sub = lane & 7, co = head * 64 + sub * 8;
    const int gw = blockIdx.x * NWAVES + wave, NGW = G * NWAVES;
    for (int t = gw; t < M; t += NGW) {
        f32x4 q0, q1; unpack8(*(const GAS v4u*)(Q + (size_t)t * 512 + co), q0, q1);
        float m = -INFINITY, l = 0.f; f32x4 a0 = (f32x4){0.f, 0.f, 0.f, 0.f}, a1 = a0;
        const unsigned* mrow = MASK + (size_t)t * 512; const int nw = (t >> 5) + 1;
        for (int w = 0; w < nw; ++w) {
            unsigned word = __builtin_amdgcn_readfirstlane(mrow[w]);
            while (word) { const int b = __builtin_ctz(word); word &= word - 1u; const int s = 32 * w + b;
                f32x4 k0, k1; unpack8(*(const GAS v4u*)(K + (size_t)s * 512 + co), k0, k1);
                f32x4 v0, v1; unpack8(*(const GAS v4u*)(V + (size_t)s * 512 + co), v0, v1);
                float d = (q0[0] * k0[0] + q0[1] * k0[1]) + (q0[2] * k0[2] + q0[3] * k0[3]) + (q1[0] * k1[0] + q1[1] * k1[1]) + (q1[2] * k1[2] + q1[3] * k1[3]);
                d += __shfl_xor(d, 1); d += __shfl_xor(d, 2); d += __shfl_xor(d, 4);
                int rel = t - s; rel = rel > 127 ? 127 : rel;
                const float x = d + RT[head * 128 + rel];
                const float mn = fmaxf(m, x), scl = __builtin_amdgcn_exp2f(m - mn), p = __builtin_amdgcn_exp2f(x - mn);
                l = l * scl + p; a0 = a0 * scl + v0 * p; a1 = a1 * scl + v1 * p; m = mn; }
        }
        const float inv = 1.0f / l;
        *(GAS v4u*)(AO + (size_t)t * 512 + co) = pack8(a0 * inv, a1 * inv);
    }
}

__device__ __forceinline__ void ln_row(const float* src, const float* g, const float* b, float* dst, bf16* dstb, int lane) {
    const GAS f32x4* xr = (const GAS f32x4*)src + lane;
    f32x4 v[4]; float s = 0.f;
#pragma unroll
    for (int j = 0; j < 4; ++j) { v[j] = xr[64 * j]; s += (v[j][0] + v[j][1]) + (v[j][2] + v[j][3]); }
    const float mean = wave_sum(s) * (1.f / D); float s2 = 0.f;
#pragma unroll
    for (int j = 0; j < 4; ++j) { v[j] = v[j] - mean; s2 += (v[j][0] * v[j][0] + v[j][1] * v[j][1]) + (v[j][2] * v[j][2] + v[j][3] * v[j][3]); }
    const float rstd = 1.f / sqrtf(wave_sum(s2) * (1.f / D) + LN_EPS);
#pragma unroll
    for (int j = 0; j < 4; ++j) { const f32x4 gg = ((const GAS f32x4*)g)[lane + 64 * j], bb = ((const GAS f32x4*)b)[lane + 64 * j]; const f32x4 y = v[j] * rstd * gg + bb;
        ((GAS f32x4*)dst)[lane + 64 * j] = y;
        if (dstb) { v2u w; w.x = cvt_pk_bf16(y[0], y[1]); w.y = cvt_pk_bf16(y[2], y[3]); ((GAS v2u*)dstb)[lane + 64 * j] = w; } }
}
__device__ __forceinline__ void ph_ln1_router(const Ptrs& P, LAS unsigned char* lds, int G) {
    const int tid = threadIdx.x, lane = tid & 63, wave = __builtin_amdgcn_readfirstlane(tid >> 6);
    const float* H1 = (const float*)(P.ws + WS_H1); float* X1 = (float*)(P.ws + WS_X1); bf16* X1B = (bf16*)(P.ws + WS_X1B);
    int* TOPI = (int*)(P.ws + WS_TOPI); float* TOPG = (float*)(P.ws + WS_TOPG); int* CNTCH = (int*)(P.ws + WS_CNTCH);
    LAS float* part = (LAS float*)lds;
    LAS unsigned* hist = (LAS unsigned*)(lds + 32768);
    for (int ch = blockIdx.x; ch < M / 64; ch += G) {
        for (int i = 0; i < 8; ++i) { const size_t row = (size_t)ch * 64 + wave * 8 + i; ln_row(H1 + row * D, P.ln1_g, P.ln1_b, X1 + row * D, X1B + row * D, lane); }
        if (tid < 32) hist[tid] = 0u;
        VM_WAIT(); __syncthreads();
        const int rg = wave >> 2, kq = wave & 3;
        f32x16 acc;
#pragma unroll
        for (int i = 0; i < 16; ++i) acc[i] = 0.f;
        const float* xrow = X1 + ((size_t)ch * 64 + rg * 32 + (lane & 31)) * D + 4 * (lane >> 5);
        const float* wr = P.w_router + (size_t)(4 * (lane >> 5)) * NE + (lane & 31);
        for (int k0 = kq * 256; k0 < kq * 256 + 256; k0 += 8) {
            const f32x4 xa = *(const GAS f32x4*)(xrow + k0);
#pragma unroll
            for (int i = 0; i < 4; ++i) acc = __builtin_amdgcn_mfma_f32_32x32x2f32(xa[i], wr[(size_t)(k0 + i) * NE], acc, 0, 0, 0);
        }
#pragma unroll
        for (int i = 0; i < 16; ++i) part[(wave * 16 + i) * 64 + lane] = acc[i];
        __syncthreads();
        if (tid < 64) {
            const int r = tid, rgg = r >> 5, rho = r & 31, ii = (rho & 3) + 4 * (rho >> 3), lh = 32 * ((rho >> 2) & 1);
            float lg[NE];
#pragma unroll
            for (int e = 0; e < NE; ++e) { float s = P.b_router[e];
#pragma unroll
                for (int q = 0; q < 4; ++q) s += part[((rgg * 4 + q) * 16 + ii) * 64 + lh + e];
                lg[e] = s; }
            float tv[4]; int ti[4];
#pragma unroll
            for (int s = 0; s < 4; ++s) { float best = -INFINITY; int bi = 0;
#pragma unroll
                for (int e = 0; e < NE; ++e) if (lg[e] > best) { best = lg[e]; bi = e; }
                tv[s] = best; ti[s] = bi;
#pragma unroll
                for (int e = 0; e < NE; ++e) if (e == bi) lg[e] = -INFINITY; }
            const float e1 = __expf(tv[1] - tv[0]), e2 = __expf(tv[2] - tv[0]), e3 = __expf(tv[3] - tv[0]); const float inv = 1.0f / (1.0f + e1 + e2 + e3);
            const size_t row = (size_t)ch * 64 + r;
            *(int4*)(TOPI + row * 4) = make_int4(ti[0], ti[1], ti[2], ti[3]);
            *(float4*)(TOPG + row * 4) = make_float4(inv, e1 * inv, e2 * inv, e3 * inv);
#pragma unroll
            for (int s = 0; s < 4; ++s) atomicAdd((unsigned*)&hist[ti[s]], 1u);
        }
        __syncthreads();
        if (tid < 32) CNTCH[ch * 32 + tid] = (int)hist[tid];
        __syncthreads();
    }
}

__device__ __forceinline__ void ph_dispatch(const Ptrs& P, LAS unsigned char* lds, int G) {
    const int tid = threadIdx.x;
    const int* TOPI = (const int*)(P.ws + WS_TOPI); const float* TOPG = (const float*)(P.ws + WS_TOPG); const int* CNTCH = (const int*)(P.ws + WS_CNTCH);
    int* ROWTOK = (int*)(P.ws + WS_ROWTOK); float* ROWGATE = (float*)(P.ws + WS_ROWGATE); int* TOKPOS = (int*)(P.ws + WS_TOKPOS); int* EXPOFF = (int*)(P.ws + WS_EXPOFF);
    LAS int* redT = (LAS int*)lds;
    LAS int* redB = redT + 512;
    LAS int* offs = redB + 512;
    LAS int* tot = offs + 40;
    LAS int* bel = tot + 32;
    LAS int* el = bel + 32;
    for (int ch = blockIdx.x; ch < M / 64; ch += G) {
        { const int e = tid & 31, part = tid >> 5; int T = 0, B = 0;
            for (int c = part * 16; c < part * 16 + 16; ++c) { const int v = CNTCH[c * 32 + e]; T += v; if (c < ch) B += v; }
            redT[part * 32 + e] = T; redB[part * 32 + e] = B; }
        __syncthreads();
        if (tid < 32) { int T = 0, B = 0; for (int q = 0; q < 16; ++q) { T += redT[q * 32 + tid]; B += redB[q * 32 + tid]; } tot[tid] = T; bel[tid] = B; }
        __syncthreads();
        if (tid == 0) { int o = 0; for (int e = 0; e < NE; ++e) { offs[e] = o; o += (tot[e] + 255) & ~255; } offs[NE] = o; }
        if (tid < 256) el[tid] = TOPI[(size_t)ch * 256 + tid];
        __syncthreads();
        if (tid < 256) { const int e = el[tid]; int rank = 0; for (int j = 0; j < tid; ++j) rank += (el[j] == e) ? 1 : 0;
            const int pos = offs[e] + bel[e] + rank; const int row = ch * 64 + (tid >> 2);
            ROWTOK[pos] = row; ROWGATE[pos] = TOPG[(size_t)ch * 256 + tid]; TOKPOS[(size_t)ch * 256 + tid] = pos; }
        if (ch < NE) { const int e = ch; for (int r = offs[e] + tot[e] + tid; r < offs[e + 1]; r += 512) { ROWTOK[r] = 0; ROWGATE[r] = 0.f; } }
        if (ch == 0 && tid <= NE) EXPOFF[tid] = offs[tid];
        __syncthreads();
    }
}

__device__ __forceinline__ void ph_combine(const Ptrs& P, int G) {
    const int tid = threadIdx.x, lane = tid & 63, wave = __builtin_amdgcn_readfirstlane(tid >> 6);
    const float* X1 = (const float*)(P.ws + WS_X1); const bf16* Y = (const bf16*)(P.ws + WS_Y); const int* TOKPOS = (const int*)(P.ws + WS_TOKPOS);
    float* HH = (float*)(P.ws + WS_HH); bf16* HHB = (bf16*)(P.ws + WS_HHB);
    const int gw = blockIdx.x * NWAVES + wave, NGW = G * NWAVES;
    for (int t = gw; t < M; t += NGW) {
        const int4 pos = *(const int4*)(TOKPOS + (size_t)t * 4);
        const int pp[4] = {pos.x, pos.y, pos.z, pos.w};
#pragma unroll
        for (int j = 0; j < 4; ++j) { f32x4 h = ((const GAS f32x4*)(X1 + (size_t)t * D))[lane + 64 * j] * ALPHA;
#pragma unroll
            for (int s = 0; s < 4; ++s) { const v2u w = ((const GAS v2u*)(Y + (size_t)pp[s] * D))[lane + 64 * j]; h[0] += bflo(w.x); h[1] += bfhi(w.x); h[2] += bflo(w.y); h[3] += bfhi(w.y); }
            ((GAS f32x4*)(HH + (size_t)t * D))[lane + 64 * j] = h;
            v2u o; o.x = cvt_pk_bf16(h[0], h[1]); o.y = cvt_pk_bf16(h[2], h[3]); ((GAS v2u*)(HHB + (size_t)t * D))[lane + 64 * j] = o; }
    }
}

__device__ __forceinline__ void ph_ln2(const Ptrs& P, int G) {
    const int tid = threadIdx.x, lane = tid & 63, wave = __builtin_amdgcn_readfirstlane(tid >> 6);
    const float* V2 = (const float*)(P.ws + WS_V2);
    const int gw = blockIdx.x * NWAVES + wave, NGW = G * NWAVES;
    for (int t = gw; t < M; t += NGW) ln_row(V2 + (size_t)t * D, P.ln2_g, P.ln2_b, P.out + (size_t)t * D, nullptr, lane);
}

constexpr int NPHASE = 15;
struct Args { Ptrs p; int ph_lo, ph_hi; };
__global__ void __launch_bounds__(NWAVES * 64, 2) mk_fwd(Args args) {
    extern __shared__ __attribute__((aligned(16))) unsigned char lds_raw[];
    LAS unsigned char* lds = (LAS unsigned char*)lds_raw;
    volatile LAS unsigned* MISC = (volatile LAS unsigned*)(lds + MISC_OFF);
    const Ptrs& P = args.p; unsigned char* ws = P.ws;
    const int tid = threadIdx.x, G = gridDim.x;
    for (int u = tid; u < (LDS_BYTES - LDSCTL_OFF) / 4; u += NWAVES * 64) ((LAS unsigned*)(lds + LDSCTL_OFF))[u] = 0u;
    __syncthreads();
    const int lo = args.ph_lo, hi = args.ph_hi;
    const bool multi = (hi - lo) > 1;
    XcdBarrier bar; bar.bar = (unsigned*)(ws + WS_CTL) + CW_BAR; bar.x = 0; bar.st = nullptr;
    if (multi) bar = xcd_barrier_post((unsigned*)(ws + WS_CTL) + CW_BAR, MISC + 8);
#ifndef PH_MASK
#define PH_MASK 0x7fff
#endif
#define IN(k) ((((PH_MASK) >> (k)) & 1) && lo <= (k) && (k) < hi)
#define SEAM(k) do { if (IN(k) && IN((k) + 1)) xcd_barrier(bar); } while (0)
    LAS int* expoff = (LAS int*)(lds + LDSCTL_OFF);

    if (IN(0)) { ph_prologue(P, lds, G); SEAM(0); }
    if (IN(1)) {
        pg8::Gemm g{(const bf16*)(ws + WS_XB), (const bf16*)(ws + WS_WIN), M, NPROJ, D}; pg8::StaticOrder S; S.init(M, NPROJ, G, (int)blockIdx.x);
        EpiProj E{ws, (const float*)(ws + WS_BIASP)};
        pg8::gemm_phase<EpiProj, pg8::StaticOrder, true, true>(lds + RING_OFF, g, S, E);
        SEAM(1);
    }
    if (IN(2)) {
#ifndef NO_CONV
        ph_conv(P, lds, G); __syncthreads();
#endif
#ifndef NO_INDEX
        ph_index_slow(P, lds, G);
#endif
        SEAM(2); }
    if (IN(3)) { ph_attn_slow(P, G); SEAM(3); }
    if (IN(4)) {
        pg8::Gemm g{(const bf16*)(ws + WS_AO), (const bf16*)(ws + WS_WOA), M, D, AW}; pg8::StaticOrder S; S.init(M, D, G, (int)blockIdx.x);
        EpiGated<false> E{(const bf16*)(ws + WS_SG), 0, nullptr, (bf16*)(ws + WS_T)};
        pg8::gemm_phase<EpiGated<false>, pg8::StaticOrder, true, true>(lds + RING_OFF, g, S, E);
        SEAM(4);
    }
    if (IN(5)) {
        pg8::Gemm g{(const bf16*)(ws + WS_CO), (const bf16*)(ws + WS_WOC), M, D, CCH}; pg8::StaticOrder S; S.init(M, D, G, (int)blockIdx.x);
        EpiGated<true> E{(const bf16*)(ws + WS_SG), 1024, (const bf16*)(ws + WS_T), (bf16*)(ws + WS_MG)};
        pg8::gemm_phase<EpiGated<true>, pg8::StaticOrder, true, true>(lds + RING_OFF, g, S, E);
        SEAM(5);
    }
    if (IN(6)) {
        pg8::Gemm g{(const bf16*)(ws + WS_MG), (const bf16*)(ws + WS_WOUT), M, D, D}; pg8::StaticOrder S; S.init(M, D, G, (int)blockIdx.x);
        EpiRes E{P.x, (float*)(ws + WS_H1)};
        pg8::gemm_phase<EpiRes, pg8::StaticOrder, true, true>(lds + RING_OFF, g, S, E);
        SEAM(6);
    }
    if (IN(7)) { ph_ln1_router(P, lds, G); SEAM(7); }
    if (IN(8)) { ph_dispatch(P, lds, G); SEAM(8); }
    if (IN(9) || IN(10)) { if (tid <= NE) expoff[tid] = ((const int*)(ws + WS_EXPOFF))[tid]; __syncthreads(); }
    if (IN(9)) {
        pg8::Gemm g{(const bf16*)(ws + WS_X1B), (const bf16*)(ws + WS_WGU), RMAX, 2 * DE, D};
        MoeOrder<true> S{expoff, 8, G, (int)blockIdx.x, (const int*)(ws + WS_ROWTOK), D, (size_t)2 * DE * D * 2};
        EpiSwiglu E{(const float*)(ws + WS_BGUP), (bf16*)(ws + WS_HB)};
        pg8::gemm_phase<EpiSwiglu, MoeOrder<true>, true, true>(lds + RING_OFF, g, S, E);
        SEAM(9);
    }
    if (IN(10)) {
        pg8::Gemm g{(const bf16*)(ws + WS_HB), (const bf16*)(ws + WS_WD), RMAX, D, DE};
        MoeOrder<false> S{expoff, 4, G, (int)blockIdx.x, nullptr, DE, (size_t)D * DE * 2};
        EpiDown E{P.b_down, (const float*)(ws + WS_ROWGATE), (bf16*)(ws + WS_Y)};
        pg8::gemm_phase<EpiDown, MoeOrder<false>, true, true>(lds + RING_OFF, g, S, E);
        SEAM(10);
    }
    if (IN(11)) { ph_combine(P, G); SEAM(11); }
    if (IN(12)) {
        pg8::Gemm g{(const bf16*)(ws + WS_PB), (const bf16*)(ws + WS_WPP), M, D, PLE}; pg8::StaticOrder S; S.init(M, D, G, (int)blockIdx.x);
        EpiPlain E{(bf16*)(ws + WS_PP)};
        pg8::gemm_phase<EpiPlain, pg8::StaticOrder, true, true>(lds + RING_OFF, g, S, E);
        SEAM(12);
    }
    if (IN(13)) {
        pg8::Gemm g{(const bf16*)(ws + WS_HHB), (const bf16*)(ws + WS_WPG), M, D, D}; pg8::StaticOrder S; S.init(M, D, G, (int)blockIdx.x);
        EpiPle E{(const float*)(ws + WS_HH), (const bf16*)(ws + WS_PP), (float*)(ws + WS_V2)};
        pg8::gemm_phase<EpiPle, pg8::StaticOrder, true, true>(lds + RING_OFF, g, S, E);
        SEAM(13);
    }
    if (IN(14)) { ph_ln2(P, G); }
#ifdef DBG_OUT
    if (lo == 15) {
        const size_t gt = (size_t)blockIdx.x * (NWAVES * 64) + tid, NT = (size_t)G * NWAVES * 64;
        for (size_t i = gt; i < (size_t)M * D; i += NT) {
#if DBG_OUT == 1
            P.out[i] = ((const float*)(ws + WS_H1))[i];
#elif DBG_OUT == 2
            P.out[i] = bf2f(((const bf16*)(ws + WS_MG))[i]);
#elif DBG_OUT == 3
            { const size_t r = i >> 10, c = i & 1023; P.out[i] = c < 512 ? bf2f(((const bf16*)(ws + WS_AO))[r * 512 + c]) : bf2f(((const bf16*)(ws + WS_CO))[r * 512 + c - 512]); }
#elif DBG_OUT == 4
            { const size_t r = i >> 10, c = i & 1023; P.out[i] = c < 512 ? (float)(((const unsigned*)(ws + WS_MASK))[r * 512 + c] & 0xffffu) : (float)(((const unsigned*)(ws + WS_MASK))[r * 512 + c - 512] >> 16); }
#elif DBG_OUT == 5
            P.out[i] = ((const float*)(ws + WS_HH))[i];
#elif DBG_OUT == 6
            P.out[i] = ((const float*)(ws + WS_X1))[i];
#elif DBG_OUT == 7
            P.out[i] = bf2f(((const bf16*)(ws + WS_T))[i]);
#elif DBG_OUT == 9
            { const size_t r = i >> 10, c = i & 1023; P.out[i] = c < 512 ? bf2f(((const bf16*)(ws + WS_Q))[r * 512 + c]) : bf2f(((const bf16*)(ws + WS_U))[r * 512 + c - 512]); }
#elif DBG_OUT == 10
            { const size_t r = i >> 10, c = i & 1023; P.out[i] = bf2f(((const bf16*)(ws + WS_WIN))[(3072 + (r & 2047)) * 1024 + c]) + ((const float*)(ws + WS_BIASP))[3072 + (i & 2047)]; }
#elif DBG_OUT == 8
            { const size_t r = i >> 10, c = i & 1023; P.out[i] = bf2f(((const bf16*)(ws + WS_SG))[r * 2048 + c]) + 2.f * bf2f(((const bf16*)(ws + WS_SG))[r * 2048 + 1024 + c]); }
#endif
        }
    }
#endif
#undef IN
#undef SEAM
}

#ifndef MK_ONE_LAUNCH
#define MK_ONE_LAUNCH 1
#endif
extern "C" void kernel_launch(void* const* d_in, const int* in_sizes, int n_in, void* d_out, int out_size, void* d_ws, size_t ws_size, hipStream_t stream) {
    static int grid = 0;
    if (grid == 0) {
        if (n_in != 24 || in_sizes[0] != M * D || out_size != M * D || ws_size < WS_END) { fprintf(stderr, "kernel_launch: unexpected shapes (n_in %d, in0 %d, out %d, ws %zu)\n", n_in, n_in > 0 ? in_sizes[0] : -1, out_size, ws_size); grid = -1; return; }
        int dev = 0, cus = 0, per_cu = 0;
        if (hipGetDevice(&dev) != hipSuccess || hipDeviceGetAttribute(&cus, hipDeviceAttributeMultiprocessorCount, dev) != hipSuccess) { grid = -1; return; }
        if (hipFuncSetAttribute((const void*)mk_fwd, hipFuncAttributeMaxDynamicSharedMemorySize, LDS_BYTES) != hipSuccess) { fprintf(stderr, "kernel_launch: hipFuncSetAttribute failed\n"); grid = -1; return; }
        if (hipOccupancyMaxActiveBlocksPerMultiprocessor(&per_cu, (const void*)mk_fwd, NWAVES * 64, LDS_BYTES) != hipSuccess || per_cu < 1) fprintf(stderr, "kernel_launch: occupancy query reports %d\n", per_cu);
        (void)hipGetLastError();
        grid = cus;
    }
    if (grid < 0) return;
    if (hipMemsetAsync((char*)d_ws + WS_CTL, 0, CTL_ZERO_BYTES, stream) != hipSuccess) return;
    Args a{};
    const float** pp = (const float**)&a.p;
    for (int i = 0; i < 24; ++i) pp[i] = (const float*)d_in[i];
    a.p.out = (float*)d_out; a.p.ws = (unsigned char*)d_ws;
#if MK_ONE_LAUNCH
    a.ph_lo = 0; a.ph_hi = NPHASE;
    hipLaunchKernelGGL(mk_fwd, dim3(grid), dim3(NWAVES * 64), LDS_BYTES, stream, a);
#else
#ifndef NRUN
#define NRUN NPHASE
#endif
#ifdef DBG_OUT
    for (int ph = 0; ph <= (DBG_OUT <= 4 ? (DBG_OUT == 1 ? 6 : DBG_OUT == 2 ? 5 : 3) : (DBG_OUT == 5 ? 11 : DBG_OUT == 6 ? 7 : DBG_OUT == 7 ? 4 : 1)); ++ph) { a.ph_lo = ph; a.ph_hi = ph + 1; hipLaunchKernelGGL(mk_fwd, dim3(grid), dim3(NWAVES * 64), LDS_BYTES, stream, a); }
    a.ph_lo = 15; a.ph_hi = 16; hipLaunchKernelGGL(mk_fwd, dim3(grid), dim3(NWAVES * 64), LDS_BYTES, stream, a);
    return;
#endif
    for (int ph = 0; ph < NRUN; ++ph) { a.ph_lo = ph; a.ph_hi = ph + 1; hipLaunchKernelGGL(mk_fwd, dim3(grid), dim3(NWAVES * 64), LDS_BYTES, stream, a); }
#endif
}
```

```cpp
#include <hip/hip_runtime.h>
#include <cstdio>
#include <cstdint>

namespace pg8 {
#define PG8_LAS __attribute__((address_space(3)))
typedef unsigned short bf16_t;
typedef short bf16x8 __attribute__((ext_vector_type(8)));
typedef float f32x4 __attribute__((ext_vector_type(4)));
typedef unsigned u32x4 __attribute__((ext_vector_type(4)));
typedef unsigned u32x2 __attribute__((ext_vector_type(2)));
constexpr int BM = 256, BK = 64, HALF = 128, HTB = HALF * BK * 2  , STAGE_BYTES = 8 * HTB, NXCD = 8, WGM = 8;

__host__ __device__ __forceinline__ int lds_byte(int r, int c) { const int st = (r >> 4) * 2 + (c >> 5), rr = r & 15, cc = c & 31, ob = rr * 64 + cc * 2; return st * 1024 + (ob ^ (((ob >> 9) & 1) << 5)); }
__host__ __device__ __forceinline__ void stage_rc(int b, int& R, int& C) { const int st = b / 1024, sb = b % 1024, swz = sb ^ (((sb >> 9) & 1) << 5); R = (st >> 1) * 16 + swz / 64; C = (st & 1) * 32 + (swz % 64) / 2; }
__host__ __device__ __forceinline__ int perm32(int rho) { const int n = rho >> 4, i = rho & 15; return 8 * (i >> 2) + 4 * n + (i & 3); }

struct Unit { int pm, pn, e; };
struct Gemm { const bf16_t* A; const bf16_t* Bt; int M, N, K; };

struct StaticOrder {
    static constexpr bool GATHER = false;
    int nM, nN, nwg, G, c;
    __host__ __device__ void init(int M, int N, int G_, int c_) { nM = M / BM; nN = N / BM; nwg = nM * nN; G = G_; c = c_; }
    __host__ __device__ bool next(int i, Unit& u) const {
        const long L = (long)i * G + c; if (L >= nwg) return false;
        int wgid = (int)L; { const int q = nwg / NXCD, r = nwg % NXCD, xcd = wgid % NXCD, off = wgid / NXCD; wgid = (xcd < r ? xcd * (q + 1) : r * (q + 1) + (xcd - r) * q) + off; }
        const int nig = WGM * nN, gid = wgid / nig, fm = gid * WGM, gsz = (nM - fm) < WGM ? (nM - fm) : WGM;
        u.pm = fm + ((wgid % nig) % gsz); u.pn = (wgid % nig) / gsz; u.e = 0; return true;
    }
    __device__ __forceinline__ const char* a_base(const Gemm& g, const Unit& u) const { return (const char*)g.A + (size_t)u.pm * ((size_t)BM * g.K * 2); }
    __device__ __forceinline__ const char* b_base(const Gemm& g, const Unit& u) const { return (const char*)g.Bt + (size_t)u.pn * ((size_t)BM * g.K * 2); }
    __device__ __forceinline__ unsigned a_rowoff(const Unit&, int, int) const { return 0u; }
};

typedef float f32x2_cv __attribute__((ext_vector_type(2))); typedef __bf16 bf16x2_cv __attribute__((ext_vector_type(2)));
__device__ __forceinline__ unsigned cvt_pk_bf16(float lo, float hi) { const f32x2_cv v = {lo, hi}; const bf16x2_cv b = __builtin_convertvector(v, bf16x2_cv); return __builtin_bit_cast(unsigned, b); }

template <class Epi, class Sched, bool ALIGN_EPI = false, bool SP2 = false>
__device__ __forceinline__ void gemm_phase(PG8_LAS unsigned char* lds, const Gemm g, const Sched& S, const Epi& E) {
    const int tid = threadIdx.x, wid = __builtin_amdgcn_readfirstlane(tid >> 6), lane = tid & 63, wr = wid >> 2, wc = wid & 3, fr = lane & 15, fq = lane >> 4;
    int K_ = g.K; asm volatile("" : "+s"(K_));
    const int K = K_, nt = K / BK;
    constexpr bool GATHER = Sched::GATHER;
    int Rr[2], Cc[2]; unsigned voffB[2];
#pragma unroll
    for (int i = 0; i < 2; ++i) { stage_rc(tid * 16 + i * 8192, Rr[i], Cc[i]); const int Rb = Epi::PERM ? ((Rr[i] & ~31) + perm32(Rr[i] & 31)) : Rr[i];
        voffB[i] = (unsigned)(Rb * K + Cc[i]) * 2u; }
    const size_t kstep = (size_t)(BK * 2);
    const size_t hstep = (size_t)HALF * K * 2;
    const unsigned ldsw = (unsigned)wid * 1024u;
    const int aoff = lds_byte(wr * 64 + fr, fq * 8), boff = lds_byte(wc * 32 + fr, fq * 8);
    unsigned vA[2][2], vN[2][2];
#define PG8_SETA(v, u) do { _Pragma("unroll") for (int _h = 0; _h < 2; ++_h) _Pragma("unroll") for (int _i = 0; _i < 2; ++_i) \
        v[_h][_i] = (GATHER ? S.a_rowoff(u, _h, Rr[_i]) : (unsigned)((_h * HALF + Rr[_i]) * K) * 2u) + (unsigned)Cc[_i] * 2u; } while (0)
#define PG8_SA(b, h) (((b) * 2 + (h)) * HTB)
#define PG8_SB(b, h) ((4 + (b) * 2 + (h)) * HTB)
#define PG8_STAGE(bufoff, gbase, voff) do { _Pragma("unroll") for (int _i = 0; _i < 2; ++_i) \
        __builtin_amdgcn_global_load_lds((const unsigned*)((const char*)(gbase) + (voff)[_i]), (PG8_LAS unsigned*)(lds + (bufoff) + ldsw + _i * 8192), 16, 0, 0); } while (0)
#define PG8_LDA(dst, b, h) do { _Pragma("unroll") for (int m = 0; m < 4; ++m) _Pragma("unroll") for (int k = 0; k < 2; ++k) dst[m][k] = *(const PG8_LAS bf16x8*)(lds + PG8_SA(b, h) + aoff + m * 2048 + k * 1024); } while (0)
#define PG8_LDB(dst, b, h) do { _Pragma("unroll") for (int n = 0; n < 2; ++n) _Pragma("unroll") for (int k = 0; k < 2; ++k) dst[n][k] = *(const PG8_LAS bf16x8*)(lds + PG8_SB(b, h) + boff + n * 2048 + k * 1024); } while (0)
#define PG8_MMA(ai, bj, At, Bt) do { __builtin_amdgcn_s_setprio(1); _Pragma("unroll") for (int m = 0; m < 4; ++m) _Pragma("unroll") for (int n = 0; n < 2; ++n) _Pragma("unroll") for (int k = 0; k < 2; ++k) \
        acc[ai][bj][m][n] = __builtin_amdgcn_mfma_f32_16x16x32_bf16(Bt[n][k], At[m][k], acc[ai][bj][m][n], 0, 0, 0); __builtin_amdgcn_s_setprio(0); } while (0)
#define PG8_WAIT_V(n) asm volatile("s_waitcnt vmcnt(" #n ")" ::: "memory")
#define PG8_WAIT_L(n) asm volatile("s_waitcnt lgkmcnt(" #n ")" ::: "memory")
#define PG8_BAR __builtin_amdgcn_s_barrier()
#define PG8_SCHED __builtin_amdgcn_sched_barrier(0)
    Unit cur, nxt; int ui = 0;
    if (!S.next(0, cur)) return;
    f32x4 acc[2][2][4][2];
#pragma unroll
    for (int a = 0; a < 2; ++a)
#pragma unroll
        for (int b = 0; b < 2; ++b)
#pragma unroll
            for (int m = 0; m < 4; ++m)
#pragma unroll
                for (int n = 0; n < 2; ++n) acc[a][b][m][n] = (f32x4){0.f, 0.f, 0.f, 0.f};
    bf16x8 At[4][2], B0[2][2], B1[2][2];
    const char* cA = S.a_base(g, cur); const char* cB = S.b_base(g, cur);
    PG8_SETA(vA, cur);
    if constexpr (GATHER) { asm volatile("s_waitcnt vmcnt(0)" ::: "memory"); asm volatile("" : "+v"(vA[0][0]), "+v"(vA[0][1]), "+v"(vA[1][0]), "+v"(vA[1][1])); }
    if constexpr (SP2) {
        PG8_STAGE(PG8_SB(0, 0), cB, voffB); PG8_STAGE(PG8_SB(0, 1), cB + hstep, voffB); PG8_STAGE(PG8_SA(0, 0), cA, vA[0]); PG8_STAGE(PG8_SA(0, 1), cA, vA[1]);
        if (wr == 1) PG8_BAR;
        PG8_WAIT_V(2); PG8_BAR;
        PG8_STAGE(PG8_SB(1, 0), cB + kstep, voffB); PG8_STAGE(PG8_SA(1, 0), cA + kstep, vA[0]); PG8_STAGE(PG8_SB(1, 1), cB + hstep + kstep, voffB);
        PG8_WAIT_V(6); PG8_BAR;
    } else {
        PG8_STAGE(PG8_SB(0, 0), cB, voffB); PG8_STAGE(PG8_SA(0, 0), cA, vA[0]); PG8_STAGE(PG8_SB(0, 1), cB + hstep, voffB); PG8_STAGE(PG8_SA(0, 1), cA, vA[1]);
        if (wr == 1) PG8_BAR;
        PG8_WAIT_V(4); PG8_BAR;
        PG8_STAGE(PG8_SB(1, 0), cB + kstep, voffB); PG8_STAGE(PG8_SA(1, 0), cA + kstep, vA[0]); PG8_STAGE(PG8_SB(1, 1), cB + hstep + kstep, voffB);
        PG8_WAIT_V(6); PG8_BAR;
    }
    for (;;) {
        const bool has_next = S.next(ui + 1, nxt);
        const char* nA = has_next ? S.a_base(g, nxt) : cA; const char* nB = has_next ? S.b_base(g, nxt) : cB;
        if constexpr (GATHER) {
            if (has_next) { PG8_SETA(vN, nxt); asm volatile("s_waitcnt vmcnt(0)" ::: "memory"); asm volatile("" : "+v"(vN[0][0]), "+v"(vN[0][1]), "+v"(vN[1][0]), "+v"(vN[1][1])); }
            else {
#pragma unroll
                for (int _h = 0; _h < 2; ++_h)
#pragma unroll
                    for (int _i = 0; _i < 2; ++_i) vN[_h][_i] = vA[_h][_i]; }
        }
        for (int t = 0; t < nt; t += 2) {
            const bool last = (t == nt - 2);
            const char* a1 = cA + (size_t)(t + 1) * kstep;
            const char* a2 = last ? nA : cA + (size_t)(t + 2) * kstep; const char* b2 = last ? nB : cB + (size_t)(t + 2) * kstep;
            const char* a3 = a2 + kstep; const char* b3 = b2 + kstep;
            unsigned wA[2][2];
#pragma unroll
            for (int _h = 0; _h < 2; ++_h)
#pragma unroll
                for (int _i = 0; _i < 2; ++_i) wA[_h][_i] = GATHER ? (last ? vN[_h][_i] : vA[_h][_i]) : vA[_h][_i];
            if constexpr (SP2) {
            PG8_LDB(B0, 0, 0); PG8_LDB(B1, 0, 1); PG8_SCHED; PG8_LDA(At, 0, 0); PG8_STAGE(PG8_SA(1, 1), a1, vA[1]);
            PG8_WAIT_V(8); PG8_WAIT_L(0); PG8_BAR; PG8_MMA(0, 0, At, B0); PG8_MMA(0, 1, At, B1); PG8_BAR; PG8_SCHED;
            PG8_LDA(At, 0, 1); PG8_STAGE(PG8_SB(0, 0), b2, voffB); PG8_STAGE(PG8_SB(0, 1), b2 + hstep, voffB); PG8_STAGE(PG8_SA(0, 0), a2, wA[0]);
            PG8_WAIT_V(8); PG8_WAIT_L(0); PG8_BAR; PG8_MMA(1, 0, At, B0); PG8_MMA(1, 1, At, B1); PG8_BAR; PG8_SCHED;
            PG8_LDB(B0, 1, 0); PG8_LDB(B1, 1, 1); PG8_SCHED; PG8_LDA(At, 1, 0); PG8_STAGE(PG8_SA(0, 1), a2, wA[1]);
            PG8_WAIT_V(8); PG8_WAIT_L(0); PG8_BAR; PG8_MMA(0, 0, At, B0); PG8_MMA(0, 1, At, B1); PG8_BAR; PG8_SCHED;
            PG8_LDA(At, 1, 1); PG8_STAGE(PG8_SB(1, 0), b3, voffB); PG8_STAGE(PG8_SB(1, 1), b3 + hstep, voffB); PG8_STAGE(PG8_SA(1, 0), a3, wA[0]);
            PG8_WAIT_V(8); PG8_WAIT_L(0); PG8_BAR; PG8_MMA(1, 0, At, B0); PG8_MMA(1, 1, At, B1); PG8_BAR; PG8_SCHED;
            } else {
            PG8_LDB(B0, 0, 0); PG8_SCHED; PG8_LDA(At, 0, 0); PG8_STAGE(PG8_SA(1, 1), a1, vA[1]);
            PG8_WAIT_L(8); PG8_BAR; PG8_WAIT_L(0); PG8_MMA(0, 0, At, B0); PG8_BAR; PG8_SCHED;
            PG8_LDB(B1, 0, 1); PG8_STAGE(PG8_SB(0, 0), b2, voffB);
            PG8_BAR; PG8_WAIT_L(0); PG8_MMA(0, 1, At, B1); PG8_BAR;
            PG8_LDA(At, 0, 1); PG8_STAGE(PG8_SA(0, 0), a2, wA[0]);
            PG8_BAR; PG8_WAIT_L(0); PG8_MMA(1, 0, At, B0); PG8_BAR; PG8_SCHED;
            PG8_STAGE(PG8_SB(0, 1), b2 + hstep, voffB);
            PG8_WAIT_V(6); PG8_BAR; PG8_MMA(1, 1, At, B1); PG8_BAR;
            PG8_LDB(B0, 1, 0); PG8_SCHED; PG8_LDA(At, 1, 0); PG8_STAGE(PG8_SA(0, 1), a2, wA[1]);
            PG8_WAIT_L(8); PG8_BAR; PG8_WAIT_L(0); PG8_MMA(0, 0, At, B0); PG8_BAR; PG8_SCHED;
            PG8_LDB(B1, 1, 1); PG8_STAGE(PG8_SB(1, 0), b3, voffB);
            PG8_BAR; PG8_WAIT_L(0); PG8_MMA(0, 1, At, B1); PG8_BAR;
            PG8_LDA(At, 1, 1); PG8_STAGE(PG8_SA(1, 0), a3, wA[0]);
            PG8_BAR; PG8_WAIT_L(0); PG8_MMA(1, 0, At, B0); PG8_BAR; PG8_SCHED;
            PG8_STAGE(PG8_SB(1, 1), b3 + hstep, voffB);
            PG8_WAIT_V(6); PG8_BAR; PG8_MMA(1, 1, At, B1); PG8_BAR;
            }
        }
        if constexpr (ALIGN_EPI) { if (wr == 0) PG8_BAR; }
        E(acc, cur, wr, wc, fr, fq);
        if (!has_next) break;
#pragma unroll
        for (int a = 0; a < 2; ++a)
#pragma unroll
            for (int b = 0; b < 2; ++b)
#pragma unroll
                for (int m = 0; m < 4; ++m)
#pragma unroll
                    for (int n = 0; n < 2; ++n) acc[a][b][m][n] = (f32x4){0.f, 0.f, 0.f, 0.f};
        cur = nxt; cA = nA; cB = nB; ++ui;
#pragma unroll
        for (int _h = 0; _h < 2; ++_h)
#pragma unroll
            for (int _i = 0; _i < 2; ++_i) vA[_h][_i] = GATHER ? vN[_h][_i] : vA[_h][_i];
        if constexpr (ALIGN_EPI) { if (wr == 1) PG8_BAR; }
    }
    PG8_WAIT_V(0);
    if constexpr (!ALIGN_EPI) { if (wr == 0) PG8_BAR; }
    PG8_BAR;
#undef PG8_SETA
#undef PG8_SA
#undef PG8_SB
#undef PG8_STAGE
#undef PG8_LDA
#undef PG8_LDB
#undef PG8_MMA
#undef PG8_WAIT_V
#undef PG8_WAIT_L
#undef PG8_BAR
#undef PG8_SCHED
}
}

constexpr int NWAVES = 8;
constexpr int M = 16384, D = 1024, AW = 512, NH = 8, HD = 64, CCH = 512, CWID = 31, NE = 32, DE = 1024, PLE = 256;
constexpr int IN_COLS = 5192, NPROJ = 5376;
constexpr float LN_EPS = 1e-5f;
constexpr float ALPHA = 1.18920711500272f;
constexpr float LOG2E = 1.4426950408889634f;
constexpr float C2 = 0.125f * LOG2E;
constexpr int RMAX = 73728;
constexpr int TOPK = 256;

constexpr size_t MiB = 1u << 20;
constexpr size_t WS_CTL = 0, CTL_ZERO_BYTES = 1 * MiB;
constexpr size_t WS_SMALL = 1 * MiB;
constexpr size_t WS_BIASP = WS_SMALL;
constexpr size_t WS_BGUP = WS_SMALL + 32 * 1024;
constexpr size_t WS_RT = WS_SMALL + 320 * 1024;
constexpr size_t WS_EXPOFF = WS_SMALL + 328 * 1024;
constexpr size_t WS_CNTCH = WS_SMALL + 332 * 1024;
constexpr size_t WS_WIN = 2 * MiB;
constexpr size_t WS_WOA = 13 * MiB, WS_WOC = 14 * MiB, WS_WOUT = 15 * MiB, WS_WPG = 17 * MiB, WS_WPP = 19 * MiB;
constexpr size_t WS_WGU = 20 * MiB;
constexpr size_t WS_WD = 148 * MiB;
constexpr size_t WS_XB = 212 * MiB;
constexpr size_t WS_Q = 252 * MiB, WS_K = 268 * MiB, WS_V = 284 * MiB, WS_QI = 300 * MiB;
constexpr size_t WS_KI = 316 * MiB;
constexpr size_t WS_WI = 318 * MiB;
constexpr size_t WS_U = 319 * MiB;
constexpr size_t WS_SG = 335 * MiB;
constexpr size_t WS_MASK = 399 * MiB;
constexpr size_t WS_AO = 431 * MiB, WS_CO = 447 * MiB;
constexpr size_t WS_T = 463 * MiB, WS_MG = 495 * MiB;
constexpr size_t WS_H1 = 527 * MiB;
constexpr size_t WS_X1 = 591 * MiB;
constexpr size_t WS_X1B = 655 * MiB;
constexpr size_t WS_ROUTE = 687 * MiB;
constexpr size_t WS_TOPI = WS_ROUTE, WS_TOPG = WS_ROUTE + 256 * 1024, WS_TOKPOS = WS_ROUTE + 512 * 1024, WS_ROWTOK = WS_ROUTE + 768 * 1024, WS_ROWGATE = WS_ROUTE + 1088 * 1024;
constexpr size_t WS_PP = 689 * MiB;
constexpr size_t WS_PB = 721 * MiB;
constexpr size_t WS_END = 729 * MiB;
constexpr size_t WS_HB = 212 * MiB;
constexpr size_t WS_Y = 356 * MiB;
constexpr size_t WS_HH = WS_H1;
constexpr size_t WS_HHB = WS_X1B;
constexpr size_t WS_V2 = WS_X1;
static_assert(WS_HB + (size_t)RMAX * 1024 * 2 <= WS_Y && WS_Y + (size_t)RMAX * 1024 * 2 <= WS_H1, "overlay map");
static_assert(WS_ROWGATE + RMAX * 4 <= WS_PP, "route map");

constexpr int CW_TMO = 0;
constexpr int CW_BAR = 4096;

constexpr int RING_OFF = 0, RING_BYTES = 131072;
constexpr int LDSCTL_OFF = RING_BYTES, MISC_OFF = LDSCTL_OFF + 320;
constexpr int LDS_BYTES = 147456;
static_assert(MISC_OFF + 128 <= LDS_BYTES, "LDS map");

#define GAS __attribute__((address_space(1)))
#define LAS __attribute__((address_space(3)))
typedef unsigned short bf16;
typedef unsigned v4u __attribute__((ext_vector_type(4)));
typedef unsigned v2u __attribute__((ext_vector_type(2)));
typedef float f32x4 __attribute__((ext_vector_type(4)));
typedef float f32x16 __attribute__((ext_vector_type(16)));
typedef short bf16x8 __attribute__((ext_vector_type(8)));
typedef GAS unsigned gu32;
typedef GAS unsigned long long gu64;
#define RLX_AGENT __ATOMIC_RELAXED, __HIP_MEMORY_SCOPE_AGENT
#define LDS_WAIT() asm volatile("s_waitcnt lgkmcnt(0)" ::: "memory")
#define VM_WAIT() asm volatile("s_waitcnt vmcnt(0)" ::: "memory")
__device__ __forceinline__ unsigned f2bf(float f) { unsigned u = __builtin_bit_cast(unsigned, f); return (u + 0x7fffu + ((u >> 16) & 1u)) >> 16; }
__device__ __forceinline__ float bf2f(unsigned b) { return __builtin_bit_cast(float, b << 16); }
__device__ __forceinline__ float bflo(unsigned w) { return __builtin_bit_cast(float, w << 16); }
__device__ __forceinline__ float bfhi(unsigned w) { return __builtin_bit_cast(float, w & 0xffff0000u); }
__device__ __forceinline__ float sigmoidf_(float x) { return __builtin_amdgcn_rcpf(1.0f + __builtin_amdgcn_exp2f(-LOG2E * x)); }
__device__ __forceinline__ LAS unsigned char* lds_opaque(LAS unsigned char* p) { unsigned a = (unsigned)(unsigned long)p; asm volatile("" : "+v"(a)); return (LAS unsigned char*)(unsigned long)a; }
__device__ __forceinline__ unsigned pk2(float lo, float hi) { return f2bf(lo) | (f2bf(hi) << 16); }

#define XB_TMO      128
#define XB_XCNT(j)  (256  + 64 * (j))
#define XB_XSUB(j)  (1280 + 64 * (j))
#define XB_XGEN(j)  (2304 + 64 * (j))
#define XB_TOP      3328
#define XB_TOPGEN   3392
#define XCD_BAR_WORDS 3456
#define XB_SPIN_CAP (1u << 18)

__device__ __forceinline__ unsigned xb_ld(unsigned* p)              { return __hip_atomic_load(p, __ATOMIC_RELAXED, __HIP_MEMORY_SCOPE_AGENT); }
__device__ __forceinline__ unsigned xb_add(unsigned* p, unsigned v) { return __hip_atomic_fetch_add(p, v, __ATOMIC_RELAXED, __HIP_MEMORY_SCOPE_AGENT); }
__device__ __forceinline__ unsigned xb_xcc_id() { return (unsigned)__builtin_amdgcn_s_getreg((3 << 11) | 20) & 0xFu; }
#define XB_SPIN(cond, bar) do { unsigned _sp = 0; while (cond) { __builtin_amdgcn_s_sleep(1); \
    if ((++_sp & 255u) == 0u) { if (xb_ld(&(bar)[XB_TMO])) break; if (_sp > XB_SPIN_CAP) { atomicAdd(&(bar)[XB_TMO], 1u); break; } } } } while (0)

struct XcdBarrier {
    unsigned* bar; unsigned x;
    volatile LAS unsigned* st;
};

__device__ __forceinline__ XcdBarrier xcd_barrier_post(unsigned* bar, volatile LAS unsigned* st) {
    XcdBarrier b; b.bar = bar; b.x = xb_xcc_id(); b.st = st;
    if (threadIdx.x == 0) (void)xb_add(&bar[XB_XCNT(b.x)], 1u);
    return b;
}
__device__ __forceinline__ void xcd_barrier_complete(unsigned* bar, unsigned x, unsigned& nloc, unsigned& nx) {
    const unsigned G = gridDim.x * gridDim.y * gridDim.z;
    unsigned sum, cnt, mine, sp = 0u;
    for (;;) {
        sum = 0u; cnt = 0u; mine = 0u;
#pragma unroll
        for (unsigned j = 0; j < 16; ++j) { const unsigned c = xb_ld(&bar[XB_XCNT(j)]); sum += c; cnt += (c > 0u) ? 1u : 0u; mine = (j == x) ? c : mine; }
        if (sum == G) break;
        __builtin_amdgcn_s_sleep(1);
        if ((++sp & 255u) == 0u) { if (xb_ld(&bar[XB_TMO])) break; if (sp > XB_SPIN_CAP) { atomicAdd(&bar[XB_TMO], 1u); break; } }
    }
    nloc = mine > 0u ? mine : 1u; nx = cnt > 0u ? cnt : 1u;
}

__device__ __forceinline__ void xcd_barrier(const XcdBarrier& b) {
    asm volatile("s_waitcnt vmcnt(0)" ::: "memory");
    __syncthreads();
    if (threadIdx.x == 0) {
        unsigned* bar = b.bar;
        __builtin_amdgcn_s_waitcnt(0);
        unsigned nloc = b.st[0], nx = b.st[1];
        if (nloc == 0u) { xcd_barrier_complete(bar, b.x, nloc, nx); b.st[0] = nloc; b.st[1] = nx; }
        const unsigned old = xb_add(&bar[XB_XSUB(b.x)], 1u);
        const unsigned gen = old / nloc;
        if (old + 1u == (gen + 1u) * nloc) {
            __builtin_amdgcn_fence(__ATOMIC_RELEASE, "agent");
            asm volatile("s_waitcnt vmcnt(0)" ::: "memory");
            const unsigned og = xb_add(&bar[XB_TOP], 1u);
            const unsigned tg = og / nx;
            if (og + 1u == (tg + 1u) * nx) xb_add(&bar[XB_TOPGEN], 1u);
            else XB_SPIN(xb_ld(&bar[XB_TOPGEN]) == tg, bar);
            __builtin_amdgcn_fence(__ATOMIC_ACQUIRE, "agent");
            xb_add(&bar[XB_XGEN(b.x)], 1u);
            asm volatile("s_waitcnt vmcnt(0)" ::: "memory");
        } else {
            XB_SPIN(xb_ld(&bar[XB_XGEN(b.x)]) == gen, bar);
            __builtin_amdgcn_fence(__ATOMIC_ACQUIRE, "agent");
            asm volatile("s_waitcnt vmcnt(0)" ::: "memory");
        }
    }
    __syncthreads();
}


__device__ __forceinline__ float wave_sum(float v) {
#pragma unroll
    for (int o = 1; o < 64; o <<= 1) v += __shfl_xor(v, o);
    return v;
}
__device__ __forceinline__ unsigned f2key(float f) { const unsigned u = __builtin_bit_cast(unsigned, f); return (u & 0x80000000u) ? ~u : (u | 0x80000000u); }
__device__ __forceinline__ int map_in(int n) {
    if (n < 2048) return n;
    if (n < 2112) return 5120 + (n - 2048);
    if (n < 2120) return 5184 + (n - 2112);
    if (n < 2632) { const int c = n - 2120; return 2048 + 8 * (c >> 2) + (c & 3); }
    if (n < 3144) { const int c = n - 2632; return 2048 + 8 * (c >> 2) + 4 + (c & 3); }
    return 3072 + (n - 3144);
}
__device__ __forceinline__ int map_gu(int n) { const int c = n & 1023; return 8 * (c >> 2) + ((n >> 10) << 2) + (c & 3); }
__device__ __forceinline__ int map_id(int n) { return n; }

template <class MapF>
__device__ __forceinline__ void transpose_item(const float* W, int K, int N, bf16* WT, LAS float* scr, int item, int lane, MapF map) {
    const int nblk = (N + 31) / 32, kb = item / nblk, nb = item % nblk, k0 = 64 * kb, n0 = 32 * nb;
    const int nn = n0 + (lane & 31);
#pragma unroll 8
    for (int i = 0; i < 32; ++i) { const int kk = 2 * i + (lane >> 5); scr[kk * 33 + (lane & 31)] = nn < N ? W[(size_t)(k0 + kk) * N + nn] : 0.f; }
    LDS_WAIT(); asm volatile("" ::: "memory");
    const int c = lane & 7;
#pragma unroll
    for (int j = 0; j < 4; ++j) { const int nl = (lane >> 3) + 8 * j; const LAS float* s = scr + (8 * c) * 33 + nl;
        v4u o; o.x = pk2(s[0 * 33], s[1 * 33]); o.y = pk2(s[2 * 33], s[3 * 33]); o.z = pk2(s[4 * 33], s[5 * 33]); o.w = pk2(s[6 * 33], s[7 * 33]);
        if (n0 + nl < N) *(GAS v4u*)(WT + (size_t)map(n0 + nl) * K + k0 + 8 * c) = o; }
    LDS_WAIT(); asm volatile("" ::: "memory");
}

struct Ptrs {
    const float *x, *p, *w_in, *b_in, *w_o_attn, *w_dw, *b_dw, *conv_ln_g, *conv_ln_b, *w_o_conv, *w_out, *ln1_g, *ln1_b, *w_router, *b_router, *w_gate_up, *b_gate_up, *w_down, *b_down,
        *w_ple_gate, *w_ple_proj, *ln2_g, *ln2_b, *rel_bias;
    float* out; unsigned char* ws;
};

__device__ __forceinline__ void ph_prologue(const Ptrs& P, LAS unsigned char* lds, int G) {
    const int tid = threadIdx.x, lane = tid & 63, wave = __builtin_amdgcn_readfirstlane(tid >> 6);
    unsigned char* ws = P.ws;
    LAS float* scr = (LAS float*)(lds + RING_OFF + wave * 16384);
    const int gw = blockIdx.x * NWAVES + wave, NGW = G * NWAVES;
    constexpr int I_IN = 16 * 163, I_OA = 8 * 32, I_OC = 8 * 32, I_OUT = 16 * 32, I_PG = 16 * 32, I_PP = 4 * 32, I_GU1 = 16 * 64, I_D1 = 16 * 32;
    constexpr int NITEMS = I_IN + I_OA + I_OC + I_OUT + I_PG + I_PP + NE * I_GU1 + NE * I_D1;
    for (int it = gw; it < NITEMS; it += NGW) {
        int r = it;
        if (r < I_IN) { transpose_item(P.w_in, D, IN_COLS, (bf16*)(ws + WS_WIN), scr, r, lane, map_in); continue; } r -= I_IN;
        if (r < I_OA) { transpose_item(P.w_o_attn, AW, D, (bf16*)(ws + WS_WOA), scr, r, lane, map_id); continue; } r -= I_OA;
        if (r < I_OC) { transpose_item(P.w_o_conv, CCH, D, (bf16*)(ws + WS_WOC), scr, r, lane, map_id); continue; } r -= I_OC;
        if (r < I_OUT) { transpose_item(P.w_out, D, D, (bf16*)(ws + WS_WOUT), scr, r, lane, map_id); continue; } r -= I_OUT;
        if (r < I_PG) { transpose_item(P.w_ple_gate, D, D, (bf16*)(ws + WS_WPG), scr, r, lane, map_id); continue; } r -= I_PG;
        if (r < I_PP) { transpose_item(P.w_ple_proj, PLE, D, (bf16*)(ws + WS_WPP), scr, r, lane, map_id); continue; } r -= I_PP;
        if (r < NE * I_GU1) { const int e = r / I_GU1; transpose_item(P.w_gate_up + (size_t)e * D * 2 * DE, D, 2 * DE, (bf16*)(ws + WS_WGU) + (size_t)e * 2 * DE * D, scr, r % I_GU1, lane, map_gu); continue; } r -= NE * I_GU1;
        { const int e = r / I_D1; transpose_item(P.w_down + (size_t)e * DE * D, DE, D, (bf16*)(ws + WS_WD) + (size_t)e * D * DE, scr, r % I_D1, lane, map_id); }
    }
    const size_t gt = (size_t)blockIdx.x * (NWAVES * 64) + tid, NT = (size_t)G * NWAVES * 64;
    for (size_t i = gt; i < (size_t)M * D / 8; i += NT) { const f32x4 a = ((const GAS f32x4*)P.x)[2 * i], b = ((const GAS f32x4*)P.x)[2 * i + 1];
        v4u o; o.x = pk2(a.x, a.y); o.y = pk2(a.z, a.w); o.z = pk2(b.x, b.y); o.w = pk2(b.z, b.w); ((GAS v4u*)(ws + WS_XB))[i] = o; }
    for (size_t i = gt; i < (size_t)M * PLE / 8; i += NT) { const f32x4 a = ((const GAS f32x4*)P.p)[2 * i], b = ((const GAS f32x4*)P.p)[2 * i + 1];
        v4u o; o.x = pk2(a.x, a.y); o.y = pk2(a.z, a.w); o.z = pk2(b.x, b.y); o.w = pk2(b.z, b.w); ((GAS v4u*)(ws + WS_PB))[i] = o; }
    float* biasp = (float*)(ws + WS_BIASP); float* bgup = (float*)(ws + WS_BGUP); float* rt = (float*)(ws + WS_RT);
    for (size_t i = gt; i < (size_t)IN_COLS; i += NT) biasp[map_in((int)i)] = P.b_in[i];
    for (size_t i = gt; i < (size_t)NE * 2 * DE; i += NT) { const int e = (int)(i >> 11), n = (int)(i & 2047); bgup[e * 2048 + map_gu(n)] = P.b_gate_up[i]; }
    for (size_t i = gt; i < (size_t)NH * 128; i += NT) { const int h = (int)(i >> 7), rel = (int)(i & 127);
        int bkt; if (rel < 16) bkt = rel; else { bkt = 16 + (int)(logf((float)rel * (1.0f / 16.0f)) / logf(8.0f) * 16.0f); bkt = bkt > 31 ? 31 : bkt; }
        rt[h * 128 + rel] = P.rel_bias[bkt * NH + h] * LOG2E; }
}

using pg8::Unit; using pg8::cvt_pk_bf16; using pg8::HALF; using pg8::BM;
__device__ __forceinline__ v4u pack8(const f32x4& a, const f32x4& b) { v4u w; w.x = cvt_pk_bf16(a[0], a[1]); w.y = cvt_pk_bf16(a[2], a[3]); w.z = cvt_pk_bf16(b[0], b[1]); w.w = cvt_pk_bf16(b[2], b[3]); return w; }
__device__ __forceinline__ f32x4 sig4(const f32x4& a) { f32x4 r; r[0] = sigmoidf_(a[0]); r[1] = sigmoidf_(a[1]); r[2] = sigmoidf_(a[2]); r[3] = sigmoidf_(a[3]); return r; }
__device__ __forceinline__ void unpack8(const v4u w, f32x4& a, f32x4& b) { a[0] = bflo(w.x); a[1] = bfhi(w.x); a[2] = bflo(w.y); a[3] = bfhi(w.y); b[0] = bflo(w.z); b[1] = bfhi(w.z); b[2] = bflo(w.w); b[3] = bfhi(w.w); }

struct EpiProj {
    static constexpr bool PERM = true;
    unsigned char* ws; const float* biasp;
    __device__ __forceinline__ void operator()(const f32x4 (&acc)[2][2][4][2], const Unit& u, int wr, int wc, int fr, int fq) const {
        const int row0 = u.pm * BM + wr * 64 + fr, cl0 = wc * 32 + 8 * fq, pn = u.pn;
        f32x4 bv[2][2];
#pragma unroll
        for (int bj = 0; bj < 2; ++bj)
#pragma unroll
            for (int n = 0; n < 2; ++n) bv[bj][n] = *(const f32x4*)(biasp + pn * BM + cl0 + bj * HALF + 4 * n);
#pragma unroll
        for (int ai = 0; ai < 2; ++ai)
#pragma unroll
            for (int m = 0; m < 4; ++m) { const size_t row = (size_t)(row0 + ai * HALF + m * 16);
#pragma unroll
                for (int bj = 0; bj < 2; ++bj) { f32x4 v0 = acc[ai][bj][m][0] + bv[bj][0], v1 = acc[ai][bj][m][1] + bv[bj][1]; const int cl = cl0 + bj * HALF;
                    if (pn < 8) { const int t = pn >> 1; if (t == 0) { v0 = v0 * C2; v1 = v1 * C2; }
                        bf16* base = (bf16*)(ws + WS_Q + (size_t)t * (WS_K - WS_Q)); *(v4u*)(base + row * 512 + (pn & 1) * 256 + cl) = pack8(v0, v1); }
                    else if (pn < 12) { const f32x4 s = sig4(v1); v2u w; w.x = cvt_pk_bf16(v0[0] * s[0], v0[1] * s[1]); w.y = cvt_pk_bf16(v0[2] * s[2], v0[3] * s[3]);
                        *(v2u*)((bf16*)(ws + WS_U) + row * 512 + (pn - 8) * 128 + (cl >> 1)) = w; }
                    else if (pn < 20) { *(v4u*)((bf16*)(ws + WS_SG) + row * 2048 + (pn - 12) * 256 + cl) = pack8(sig4(v0), sig4(v1)); }
                    else { if (cl < 64) *(v4u*)((bf16*)(ws + WS_KI) + row * 64 + cl) = pack8(v0, v1);
                           else if (cl == 64) { float* wi = (float*)(ws + WS_WI) + row * 8; *(f32x4*)wi = v0; *(f32x4*)(wi + 4) = v1; } }
                } }
    }
};
template <bool ADD> struct EpiGated {
    static constexpr bool PERM = true;
    const bf16* G; int goff; const bf16* T; bf16* O;
    __device__ __forceinline__ void operator()(const f32x4 (&acc)[2][2][4][2], const Unit& u, int wr, int wc, int fr, int fq) const {
        const int row0 = u.pm * BM + wr * 64 + fr, col0 = u.pn * BM + wc * 32 + 8 * fq;
#pragma unroll
        for (int ai = 0; ai < 2; ++ai)
#pragma unroll
            for (int m = 0; m < 4; ++m) { const size_t row = (size_t)(row0 + ai * HALF + m * 16);
#pragma unroll
                for (int bj = 0; bj < 2; ++bj) { const int col = col0 + bj * HALF; f32x4 g0, g1; unpack8(*(const v4u*)(G + row * 2048 + goff + col), g0, g1);
                    f32x4 v0 = acc[ai][bj][m][0] * g0, v1 = acc[ai][bj][m][1] * g1;
                    if (ADD) { f32x4 t0, t1; unpack8(*(const v4u*)(T + row * 1024 + col), t0, t1); v0 = v0 + t0; v1 = v1 + t1; }
                    *(v4u*)(O + row * 1024 + col) = pack8(v0, v1); } }
    }
};
struct EpiRes {
    static constexpr bool PERM = false;
    const float* X; float* O;
    __device__ __forceinline__ void operator()(const f32x4 (&acc)[2][2][4][2], const Unit& u, int wr, int wc, int fr, int fq) const {
        const int row0 = u.pm * BM + wr * 64 + fr, col0 = u.pn * BM + wc * 32 + 4 * fq;
#pragma unroll
        for (int ai = 0; ai < 2; ++ai)
#pragma unroll
            for (int m = 0; m < 4; ++m) { const size_t off = (size_t)(row0 + ai * HALF + m * 16) * D + col0;
#pragma unroll
                for (int bj = 0; bj < 2; ++bj)
#pragma unroll
                    for (int n = 0; n < 2; ++n) { const f32x4 xv = *(const f32x4*)(X + off + bj * HALF + n * 16); *(f32x4*)(O + off + bj * HALF + n * 16) = xv * ALPHA + acc[ai][bj][m][n]; }
                asm volatile("" ::: "memory"); }
    }
};
struct EpiSwiglu {
    static constexpr bool PERM = true;
    const float* bgup; bf16* HB;
    __device__ __forceinline__ void operator()(const f32x4 (&acc)[2][2][4][2], const Unit& u, int wr, int wc, int fr, int fq) const {
        const int row0 = u.pm * BM + wr * 64 + fr, cl0 = u.pn * BM + wc * 32 + 8 * fq;
        f32x4 bv[2][2];
#pragma unroll
        for (int bj = 0; bj < 2; ++bj)
#pragma unroll
            for (int n = 0; n < 2; ++n) bv[bj][n] = *(const f32x4*)(bgup + u.e * 2048 + cl0 + bj * HALF + 4 * n);
#pragma unroll
        for (int ai = 0; ai < 2; ++ai)
#pragma unroll
            for (int m = 0; m < 4; ++m) { const size_t row = (size_t)(row0 + ai * HALF + m * 16);
#pragma unroll
                for (int bj = 0; bj < 2; ++bj) { const f32x4 g = acc[ai][bj][m][0] + bv[bj][0], uu = acc[ai][bj][m][1] + bv[bj][1]; float a[4];
#pragma unroll
                    for (int j = 0; j < 4; ++j) { const float gg = fminf(g[j], 7.0f), uc = fminf(fmaxf(uu[j], -7.0f), 7.0f); a[j] = (uc + 1.0f) * gg * sigmoidf_(1.702f * gg); }
                    v2u w; w.x = cvt_pk_bf16(a[0], a[1]); w.y = cvt_pk_bf16(a[2], a[3]);
                    *(v2u*)(HB + row * 1024 + ((cl0 + bj * HALF) >> 1)) = w; } }
    }
};
struct EpiDown {
    static constexpr bool PERM = true;
    const float* bd; const float* rowgate; bf16* Y;
    __device__ __forceinline__ void operator()(const f32x4 (&acc)[2][2][4][2], const Unit& u, int wr, int wc, int fr, int fq) const {
        const int row0 = u.pm * BM + wr * 64 + fr, col0 = u.pn * BM + wc * 32 + 8 * fq;
        f32x4 bv[2][2];
#pragma unroll
        for (int bj = 0; bj < 2; ++bj)
#pragma unroll
            for (int n = 0; n < 2; ++n) bv[bj][n] = *(const f32x4*)(bd + u.e * 1024 + col0 + bj * HALF + 4 * n);
#pragma unroll
        for (int ai = 0; ai < 2; ++ai)
#pragma unroll
            for (int m = 0; m < 4; ++m) { const size_t row = (size_t)(row0 + ai * HALF + m * 16); const float gt = rowgate[row];
#pragma unroll
                for (int bj = 0; bj < 2; ++bj) *(v4u*)(Y + row * 1024 + col0 + bj * HALF) = pack8((acc[ai][bj][m][0] + bv[bj][0]) * gt, (acc[ai][bj][m][1] + bv[bj][1]) * gt); }
    }
};
struct EpiPlain {
    static constexpr bool PERM = true;
    bf16* O;
    __device__ __forceinline__ void operator()(const f32x4 (&acc)[2][2][4][2], const Unit& u, int wr, int wc, int fr, int fq) const {
        const int row0 = u.pm * BM + wr * 64 + fr, col0 = u.pn * BM + wc * 32 + 8 * fq;
#pragma unroll
        for (int ai = 0; ai < 2; ++ai)
#pragma unroll
            for (int m = 0; m < 4; ++m) { const size_t row = (size_t)(row0 + ai * HALF + m * 16);
#pragma unroll
                for (int bj = 0; bj < 2; ++bj) *(v4u*)(O + row * 1024 + col0 + bj * HALF) = pack8(acc[ai][bj][m][0], acc[ai][bj][m][1]); }
    }
};
struct EpiPle {
    static constexpr bool PERM = false;
    const float* HH; const bf16* PP; float* O;
    __device__ __forceinline__ void operator()(const f32x4 (&acc)[2][2][4][2], const Unit& u, int wr, int wc, int fr, int fq) const {
        const int row0 = u.pm * BM + wr * 64 + fr, col0 = u.pn * BM + wc * 32 + 4 * fq;
#pragma unroll
        for (int ai = 0; ai < 2; ++ai)
#pragma unroll
            for (int m = 0; m < 4; ++m) { const size_t off = (size_t)(row0 + ai * HALF + m * 16) * D + col0;
#pragma unroll
                for (int bj = 0; bj < 2; ++bj)
#pragma unroll
                    for (int n = 0; n < 2; ++n) { const size_t o = off + bj * HALF + n * 16; const f32x4 hv = *(const f32x4*)(HH + o); const v2u pw = *(const v2u*)(PP + o);
                        f32x4 pp; pp[0] = bflo(pw.x); pp[1] = bfhi(pw.x); pp[2] = bflo(pw.y); pp[3] = bfhi(pw.y);
                        *(f32x4*)(O + o) = hv + sig4(acc[ai][bj][m][n]) * pp; }
                asm volatile("" ::: "memory"); }
    }
};

template <bool GATH> struct MoeOrder {
    static constexpr bool GATHER = GATH;
    const LAS int* off; int NT, G, c; const int* rowtok; int K; size_t bstride;
    __device__ __forceinline__ bool next(int i, Unit& u) const {
        int L = i * G + c, cum = 0;
        for (int e = 0; e < NE; ++e) { const int tiles = (off[e + 1] - off[e]) >> 8, nu = tiles * NT;
            if (L < cum + nu) { const int loc = L - cum; u.e = e; u.pm = (off[e] >> 8) + loc % tiles; u.pn = loc / tiles; return true; }
            cum += nu; }
        return false;
    }
    __device__ __forceinline__ const char* a_base(const pg8::Gemm& g, const Unit& u) const { return GATH ? (const char*)g.A : (const char*)g.A + (size_t)u.pm * ((size_t)BM * g.K * 2); }
    __device__ __forceinline__ const char* b_base(const pg8::Gemm& g, const Unit& u) const { return (const char*)g.Bt + (size_t)u.e * bstride + (size_t)u.pn * ((size_t)BM * g.K * 2); }
    __device__ __forceinline__ unsigned a_rowoff(const Unit& u, int h, int R) const { return (unsigned)rowtok[u.pm * BM + h * HALF + R] * (unsigned)(K * 2); }
};

__device__ __forceinline__ void ph_conv(const Ptrs& P, LAS unsigned char* lds, int G) {
    const int tid = threadIdx.x, lane = tid & 63, wave = __builtin_amdgcn_readfirstlane(tid >> 6);
    const bf16* U = (const bf16*)(P.ws + WS_U); bf16* CO = (bf16*)(P.ws + WS_CO);
    LAS bf16* ul = (LAS bf16*)(lds);
    LAS float* yl = (LAS float*)(lds + 65536);
    float w[CWID];
#pragma unroll
    for (int j = 0; j < CWID; ++j) w[j] = P.w_dw[j * CCH + tid];
    const float bdw = P.b_dw[tid];
    f32x4 lg[2], lb[2];
    lg[0] = *(const f32x4*)(P.conv_ln_g + 8 * lane); lg[1] = *(const f32x4*)(P.conv_ln_g + 8 * lane + 4);
    lb[0] = *(const f32x4*)(P.conv_ln_b + 8 * lane); lb[1] = *(const f32x4*)(P.conv_ln_b + 8 * lane + 4);
    for (int ch = blockIdx.x; ch < M / 32; ch += G) {
        const int t0 = ch * 32;
        for (int i = tid; i < 62 * 64; i += 512) { const int r = i >> 6, c8 = i & 63; const int t = t0 - 30 + r;
            v4u v = (v4u){0u, 0u, 0u, 0u}; if (t >= 0) v = *(const GAS v4u*)(U + (size_t)t * CCH + c8 * 8);
            *(LAS v4u*)(ul + r * CCH + c8 * 8) = v; }
        __syncthreads();
        float uu[62];
#pragma unroll
        for (int r = 0; r < 62; ++r) uu[r] = bf2f(ul[r * CCH + tid]);
        float acc[32];
#pragma unroll
        for (int i = 0; i < 32; ++i) { float a = bdw;
#pragma unroll
            for (int j = 0; j < CWID; ++j) a += w[j] * uu[i + j];
            acc[i] = a; }
#pragma unroll
        for (int i = 0; i < 32; ++i) yl[i * CCH + tid] = acc[i];
        __syncthreads();
#pragma unroll
        for (int q = 0; q < 4; ++q) { const int tt = wave + 8 * q;
            f32x4 a = *(const LAS f32x4*)(yl + tt * CCH + 8 * lane), b = *(const LAS f32x4*)(yl + tt * CCH + 8 * lane + 4);
            const float mean = wave_sum((a[0] + a[1]) + (a[2] + a[3]) + (b[0] + b[1]) + (b[2] + b[3])) * (1.0f / CCH);
            a = a - mean; b = b - mean;
            const float var = wave_sum((a[0] * a[0] + a[1] * a[1]) + (a[2] * a[2] + a[3] * a[3]) + (b[0] * b[0] + b[1] * b[1]) + (b[2] * b[2] + b[3] * b[3])) * (1.0f / CCH);
            const float rstd = 1.0f / sqrtf(var + LN_EPS);
            a = a * rstd * lg[0] + lb[0]; b = b * rstd * lg[1] + lb[1];
            a = a * sig4(a); b = b * sig4(b);
            *(GAS v4u*)(CO + (size_t)(t0 + tt) * CCH + 8 * lane) = pack8(a, b); }
        __syncthreads();
    }
}

__device__ __forceinline__ void ph_index_slow(const Ptrs& P, LAS unsigned char* lds, int G) {
    const int tid = threadIdx.x, lane = tid & 63, wave = __builtin_amdgcn_readfirstlane(tid >> 6);
    const bf16* QI = (const bf16*)(P.ws + WS_QI); const bf16* KI = (const bf16*)(P.ws + WS_KI); const float* WI = (const float*)(P.ws + WS_WI);
    unsigned* MASK = (unsigned*)(P.ws + WS_MASK);
    LAS float* sc = (LAS float*)lds;
    LAS float* qs = (LAS float*)lds_opaque(lds + 65536);
    LAS unsigned* hist = (LAS unsigned*)(lds + 65536 + 2048);
    LAS unsigned* ctl = hist + 256;
    LAS float* wsm = (LAS float*)(ctl + 8);
    for (int t = blockIdx.x; t < M; t += G) {
        qs[tid] = bf2f(QI[(size_t)t * 512 + tid]); if (tid < 8) wsm[tid] = WI[(size_t)t * 8 + tid];
        __syncthreads();
        const int n = t + 1;
        for (int s = tid; s < n; s += 512) {
            asm volatile("" ::: "memory");
            float d[8];
#pragma unroll
            for (int h = 0; h < 8; ++h) d[h] = 0.f;
#pragma unroll
            for (int c = 0; c < 8; ++c) { const v4u v = *(const GAS v4u*)(KI + (size_t)s * 64 + c * 8);
                const float k0 = bflo(v.x), k1 = bfhi(v.x), k2 = bflo(v.y), k3 = bfhi(v.y), k4 = bflo(v.z), k5 = bfhi(v.z), k6 = bflo(v.w), k7 = bfhi(v.w);
#pragma unroll
                for (int h = 0; h < 8; ++h) { const f32x4 qa = *(const LAS f32x4*)(qs + h * 64 + c * 8), qb = *(const LAS f32x4*)(qs + h * 64 + c * 8 + 4);
                    d[h] += (qa[0] * k0 + qa[1] * k1) + (qa[2] * k2 + qa[3] * k3) + (qb[0] * k4 + qb[1] * k5) + (qb[2] * k6 + qb[3] * k7); }
                __builtin_amdgcn_sched_barrier(0); }
            float score = 0.f;
#pragma unroll
            for (int h = 0; h < 8; ++h) score += wsm[h] * fmaxf(d[h], 0.f);
            sc[s] = score;
        }
        __syncthreads();
        unsigned tkey = 0u;
        if (n > TOPK) {
            unsigned prefix = 0u; int krem = TOPK;
            for (int shift = 24; shift >= 0; shift -= 8) {
                if (tid < 256) hist[tid] = 0u;
                __syncthreads();
                for (int s = tid; s < n; s += 512) { const unsigned key = f2key(sc[s]); const bool match = (shift == 24) ? true : ((key >> (shift + 8)) == (prefix >> (shift + 8)));
                    if (match) atomicAdd((unsigned*)&hist[(key >> shift) & 255u], 1u); }
                __syncthreads();
                if (wave == 0) {
                    unsigned c0 = hist[4 * lane], c1 = hist[4 * lane + 1], c2 = hist[4 * lane + 2], c3 = hist[4 * lane + 3];
                    const unsigned tot = c0 + c1 + c2 + c3; unsigned suf = tot;
#pragma unroll
                    for (int o = 1; o < 64; o <<= 1) { const unsigned v = __shfl_down(suf, o); if (lane + o < 64) suf += v; }
                    const unsigned above = suf - tot;
                    if (suf >= (unsigned)krem && above < (unsigned)krem) {
                        unsigned cum = above; int digit; unsigned newk;
                        if (cum + c3 >= (unsigned)krem) { digit = 4 * lane + 3; newk = krem - cum; }
                        else { cum += c3; if (cum + c2 >= (unsigned)krem) { digit = 4 * lane + 2; newk = krem - cum; }
                            else { cum += c2; if (cum + c1 >= (unsigned)krem) { digit = 4 * lane + 1; newk = krem - cum; } else { cum += c1; digit = 4 * lane; newk = krem - cum; } } }
                        ctl[0] = prefix | ((unsigned)digit << shift); ctl[1] = newk;
                    }
                }
                __syncthreads();
                prefix = ctl[0]; krem = (int)ctl[1];
            }
            tkey = prefix;
        }
        for (int c = wave; c < 256; c += 8) { const int s = 64 * c + lane; const bool bit = (s < n) && (f2key(sc[s < n ? s : 0]) >= tkey);
            const unsigned long long m = __ballot(bit);
            if (lane == 0) { MASK[(size_t)t * 512 + 2 * c] = (unsigned)m; MASK[(size_t)t * 512 + 2 * c + 1] = (unsigned)(m >> 32); } }
        __syncthreads();
    }
}


constexpr int IX_CAP = 640, IX_LIM = IX_CAP - 32;
__device__ __forceinline__ float key2f(unsigned k) { const unsigned u = (k & 0x80000000u) ? (k & 0x7fffffffu) : ~k; return __builtin_bit_cast(float, u); }
__device__ __forceinline__ int lanes_below(unsigned long long m) { return (int)__builtin_amdgcn_mbcnt_hi((unsigned)(m >> 32), __builtin_amdgcn_mbcnt_lo((unsigned)m, 0u)); }
__device__ __forceinline__ float ix_compact(LAS float* v, LAS unsigned short* ix, LAS unsigned* hist, int n, int lane) {
    unsigned key[10]; unsigned id[10]; unsigned vm = 0u;
#pragma unroll
    for (int j = 0; j < 10; ++j) { const int i = j * 64 + lane; const bool ok = i < n; key[j] = ok ? f2key(v[ok ? i : 0]) : 0u; id[j] = ok ? (unsigned)ix[ok ? i : 0] : 0u; vm |= ok ? (1u << j) : 0u; }
    unsigned prefix = 0u; int krem = TOPK;
#pragma unroll
    for (int shift = 24; shift >= 0; shift -= 8) {
        *(LAS v4u*)(hist + 4 * lane) = (v4u){0u, 0u, 0u, 0u};
        LDS_WAIT();
#pragma unroll
        for (int j = 0; j < 10; ++j) { const bool match = ((vm >> j) & 1u) && (shift == 24 ? true : ((key[j] >> ((shift + 8) & 31)) == (prefix >> ((shift + 8) & 31))));
            if (match) __hip_atomic_fetch_add(hist + ((key[j] >> shift) & 255u), 1u, __ATOMIC_RELAXED, __HIP_MEMORY_SCOPE_WAVEFRONT); }
        LDS_WAIT();
        const v4u c = *(const LAS v4u*)(hist + 4 * lane);
        const unsigned tot = (c.x + c.y) + (c.z + c.w); unsigned suf = tot;
#pragma unroll
        for (int o = 1; o < 64; o <<= 1) { const unsigned t = __shfl_down(suf, o); if (lane + o < 64) suf += t; }
        const unsigned above = suf - tot, kr = (unsigned)krem;
        const bool mine = (suf >= kr) && (above < kr);
        unsigned cum = above; int digit; unsigned newk;
        if (cum + c.w >= kr) { digit = 4 * lane + 3; newk = kr - cum; }
        else { cum += c.w; if (cum + c.z >= kr) { digit = 4 * lane + 2; newk = kr - cum; }
            else { cum += c.z; if (cum + c.y >= kr) { digit = 4 * lane + 1; newk = kr - cum; } else { cum += c.y; digit = 4 * lane; newk = kr - cum; } } }
        const unsigned long long mm = __ballot(mine);
        const int src = mm ? (int)__builtin_ctzll(mm) : 0;
        digit = __shfl(digit, src); newk = __shfl(newk, src);
        prefix |= ((unsigned)digit << shift); krem = (int)newk;
        LDS_WAIT();
    }
    const unsigned tkey = prefix;
    int kept = 0, ties = 0;
#pragma unroll
    for (int j = 0; j < 10; ++j) { const bool ok = (vm >> j) & 1u; const bool gt = ok && key[j] > tkey, eq = ok && key[j] == tkey;
        const unsigned long long meq = __ballot(eq); const bool keepeq = eq && (ties + lanes_below(meq) < krem); ties += __builtin_popcountll(meq);
        const bool keep = gt || keepeq; const unsigned long long mk = __ballot(keep); const int pos = kept + lanes_below(mk);
        if (keep) { v[pos] = key2f(key[j]); ix[pos] = (unsigned short)id[j]; }
        kept += __builtin_popcountll(mk); }
    LDS_WAIT();
    return key2f(tkey);
}
__device__ __forceinline__ void ph_index_fast(const Ptrs& P, LAS unsigned char* lds, int G) {
    const int tid = threadIdx.x, lane = tid & 63, wave = __builtin_amdgcn_readfirstlane(tid >> 6), l32 = lane & 31, hi = lane >> 5;
    const bf16* QI = (const bf16*)(P.ws + WS_QI); const bf16* KI = (const bf16*)(P.ws + WS_KI); const float* WI = (const float*)(P.ws + WS_WI);
    unsigned* MASK = (unsigned*)(P.ws + WS_MASK);
    LAS unsigned char* wl = lds + wave * 16384;
    LAS float* vals = (LAS float*)wl;
    LAS unsigned short* idxs = (LAS unsigned short*)(wl + 10240);
    LAS unsigned* hist = (LAS unsigned*)(wl + 15360);
    LAS unsigned* bm = (LAS unsigned*)wl;
    const int rho = l32, jA = 2 * ((rho >> 2) & 1) + (rho >> 4), headA = 4 * ((rho >> 3) & 1) + (rho & 3);
    for (int b2 = blockIdx.x; b2 < 256; b2 += G)
        for (int half = 0; half < 2; ++half) {
            const int qblk = half ? 511 - b2 : b2, t0 = qblk * 32 + wave * 4;
            bf16x8 A[4];
#pragma unroll
            for (int ks = 0; ks < 4; ++ks) A[ks] = *(const GAS bf16x8*)(QI + (size_t)(t0 + jA) * 512 + headA * 64 + ks * 16 + hi * 8);
            float w[2][8];
#pragma unroll
            for (int jj = 0; jj < 2; ++jj) { const f32x4 a = *(const GAS f32x4*)(WI + (size_t)(t0 + 2 * hi + jj) * 8), b = *(const GAS f32x4*)(WI + (size_t)(t0 + 2 * hi + jj) * 8 + 4);
                w[jj][0] = a[0]; w[jj][1] = a[1]; w[jj][2] = a[2]; w[jj][3] = a[3]; w[jj][4] = b[0]; w[jj][5] = b[1]; w[jj][6] = b[2]; w[jj][7] = b[3]; }
            int cnt[4] = {0, 0, 0, 0}; float tau[4] = {-INFINITY, -INFINITY, -INFINITY, -INFINITY};
            const int nkt = (t0 >> 5) + 1, qt0 = t0 + 2 * hi;
            bf16x8 B[4], Bn[4];
#pragma unroll
            for (int ks = 0; ks < 4; ++ks) B[ks] = *(const GAS bf16x8*)(KI + (size_t)l32 * 64 + ks * 16 + hi * 8);
            for (int kt = 0; kt <= nkt; ++kt) {
                if (kt < nkt) {
                    const int ktn = (kt + 1 < nkt) ? kt + 1 : kt;
#pragma unroll
                    for (int ks = 0; ks < 4; ++ks) Bn[ks] = *(const GAS bf16x8*)(KI + (size_t)(ktn * 32 + l32) * 64 + ks * 16 + hi * 8);
                    f32x16 acc;
#pragma unroll
                    for (int i = 0; i < 16; ++i) acc[i] = 0.f;
#pragma unroll
                    for (int ks = 0; ks < 4; ++ks) acc = __builtin_amdgcn_mfma_f32_32x32x16_bf16(A[ks], B[ks], acc, 0, 0, 0);
                    float s0 = 0.f, s1 = 0.f;
#pragma unroll
                    for (int h = 0; h < 8; ++h) { s0 += w[0][h] * fmaxf(acc[h], 0.f); s1 += w[1][h] * fmaxf(acc[8 + h], 0.f); }
                    const int key = kt * 32 + l32;
                    const float ta0 = hi ? tau[2] : tau[0], ta1 = hi ? tau[3] : tau[1];
                    const bool p0 = (s0 > ta0) && (key <= qt0), p1 = (s1 > ta1) && (key <= qt0 + 1);
                    const unsigned long long m0 = __ballot(p0), m1 = __ballot(p1);
                    if (m0) { const unsigned lo = (unsigned)m0, hh = (unsigned)(m0 >> 32); const int pos = hi ? cnt[2] + (int)__builtin_amdgcn_mbcnt_hi(hh, 0u) : cnt[0] + (int)__builtin_amdgcn_mbcnt_lo(lo, 0u);
                        if (p0) { const int q = 2 * hi; vals[q * IX_CAP + pos] = s0; idxs[q * IX_CAP + pos] = (unsigned short)key; }
                        cnt[0] += __builtin_popcount(lo); cnt[2] += __builtin_popcount(hh); }
                    if (m1) { const unsigned lo = (unsigned)m1, hh = (unsigned)(m1 >> 32); const int pos = hi ? cnt[3] + (int)__builtin_amdgcn_mbcnt_hi(hh, 0u) : cnt[1] + (int)__builtin_amdgcn_mbcnt_lo(lo, 0u);
                        if (p1) { const int q = 2 * hi + 1; vals[q * IX_CAP + pos] = s1; idxs[q * IX_CAP + pos] = (unsigned short)key; }
                        cnt[1] += __builtin_popcount(lo); cnt[3] += __builtin_popcount(hh); }
#pragma unroll
                    for (int ks = 0; ks < 4; ++ks) B[ks] = Bn[ks];
                }
                const int lim = (kt == nkt) ? TOPK : IX_LIM;
                if (cnt[0] > lim || cnt[1] > lim || cnt[2] > lim || cnt[3] > lim) {
                    LDS_WAIT();
#pragma unroll
                    for (int q = 0; q < 4; ++q) if (cnt[q] > lim) { tau[q] = ix_compact(vals + q * IX_CAP, idxs + q * IX_CAP, hist, cnt[q], lane); cnt[q] = TOPK; }
                }
            }
            LDS_WAIT();
#pragma unroll
            for (int r = 0; r < 8; ++r) *(LAS v4u*)(bm + r * 256 + lane * 4) = (v4u){0u, 0u, 0u, 0u};
            LDS_WAIT();
#pragma unroll
            for (int q = 0; q < 4; ++q)
#pragma unroll
                for (int j = 0; j < 4; ++j) { const int i = j * 64 + lane; if (i < cnt[q]) { const unsigned k = idxs[q * IX_CAP + i]; __hip_atomic_fetch_or(bm + q * 512 + (k >> 5), 1u << (k & 31u), __ATOMIC_RELAXED, __HIP_MEMORY_SCOPE_WAVEFRONT); } }
            LDS_WAIT();
#pragma unroll
            for (int q = 0; q < 4; ++q)
#pragma unroll
                for (int r = 0; r < 2; ++r) *(GAS v4u*)(MASK + (size_t)(t0 + q) * 512 + r * 256 + lane * 4) = *(const LAS v4u*)(bm + q * 512 + r * 256 + lane * 4);
            LDS_WAIT();
        }
}

__device__ __forceinline__ void ph_attn_slow(const Ptrs& P, int G) {
    const int tid = threadIdx.x, lane = tid & 63, wave = __builtin_amdgcn_readfirstlane(tid >> 6);
    const bf16* Q = (const bf16*)(P.ws + WS_Q); const bf16* K = (const bf16*)(P.ws + WS_K); const bf16* V = (const bf16*)(P.ws + WS_V);
    const unsigned* MASK = (const unsigned*)(P.ws + WS_MASK); const float* RT = (const float*)(P.ws + WS_RT); bf16* AO = (bf16*)(P.ws + WS_AO);
    const int head = lane >> 3, sub = lane & 7, co = head * 64 + sub * 8;
    const int gw = blockIdx.x * NWAVES + wave, NGW = G * NWAVES;
    for (int t = gw; t < M; t += NGW) {
        f32x4 q0, q1; unpack8(*(const GAS v4u*)(Q + (size_t)t * 512 + co), q0, q1);
        float m = -INFINITY, l = 0.f; f32x4 a0 = (f32x4){0.f, 0.f, 0.f, 0.f}, a1 = a0;
        const unsigned* mrow = MASK + (size_t)t * 512; const int nw = (t >> 5) + 1;
        for (int w = 0; w < nw; ++w) {
            unsigned word = __builtin_amdgcn_readfirstlane(mrow[w]);
            while (word) { const int b = __builtin_ctz(word); word &= word - 1u; const int s = 32 * w + b;
                f32x4 k0, k1; unpack8(*(const GAS v4u*)(K + (size_t)s * 512 + co), k0, k1);
                f32x4 v0, v1; unpack8(*(const GAS v4u*)(V + (size_t)s * 512 + co), v0, v1);
                float d = (q0[0] * k0[0] + q0[1] * k0[1]) + (q0[2] * k0[2] + q0[3] * k0[3]) + (q1[0] * k1[0] + q1[1] * k1[1]) + (q1[2] * k1[2] + q1[3] * k1[3]);
                d += __shfl_xor(d, 1); d += __shfl_xor(d, 2); d += __shfl_xor(d, 4);
                int rel = t - s; rel = rel > 127 ? 127 : rel;
                const float x = d + RT[head * 128 + rel];
                const float mn = fmaxf(m, x), scl = __builtin_amdgcn_exp2f(m - mn), p = __builtin_amdgcn_exp2f(x - mn);
                l = l * scl + p; a0 = a0 * scl + v0 * p; a1 = a1 * scl + v1 * p; m = mn; }
        }
        const float inv = 1.0f / l;
        *(GAS v4u*)(AO + (size_t)t * 512 + co) = pack8(a0 * inv, a1 * inv);
    }
}

__device__ __forceinline__ void ln_row(const float* src, const float* g, const float* b, float* dst, bf16* dstb, int lane) {
    const GAS f32x4* xr = (const GAS f32x4*)src + lane;
    f32x4 v[4]; float s = 0.f;
#pragma unroll
    for (int j = 0; j < 4; ++j) { v[j] = xr[64 * j]; s += (v[j][0] + v[j][1]) + (v[j][2] + v[j][3]); }
    const float mean = wave_sum(s) * (1.f / D); float s2 = 0.f;
#pragma unroll
    for (int j = 0; j < 4; ++j) { v[j] = v[j] - mean; s2 += (v[j][0] * v[j][0] + v[j][1] * v[j][1]) + (v[j][2] * v[j][2] + v[j][3] * v[j][3]); }
    const float rstd = 1.f / sqrtf(wave_sum(s2) * (1.f / D) + LN_EPS);
#pragma unroll
    for (int j = 0; j < 4; ++j) { const f32x4 gg = ((const GAS f32x4*)g)[lane + 64 * j], bb = ((const GAS f32x4*)b)[lane + 64 * j]; const f32x4 y = v[j] * rstd * gg + bb;
        ((GAS f32x4*)dst)[lane + 64 * j] = y;
        if (dstb) { v2u w; w.x = cvt_pk_bf16(y[0], y[1]); w.y = cvt_pk_bf16(y[2], y[3]); ((GAS v2u*)dstb)[lane + 64 * j] = w; } }
}
__device__ __forceinline__ void ph_ln1_router(const Ptrs& P, LAS unsigned char* lds, int G) {
    const int tid = threadIdx.x, lane = tid & 63, wave = __builtin_amdgcn_readfirstlane(tid >> 6);
    const float* H1 = (const float*)(P.ws + WS_H1); float* X1 = (float*)(P.ws + WS_X1); bf16* X1B = (bf16*)(P.ws + WS_X1B);
    int* TOPI = (int*)(P.ws + WS_TOPI); float* TOPG = (float*)(P.ws + WS_TOPG); int* CNTCH = (int*)(P.ws + WS_CNTCH);
    LAS float* part = (LAS float*)lds;
    LAS unsigned* hist = (LAS unsigned*)(lds + 32768);
    for (int ch = blockIdx.x; ch < M / 64; ch += G) {
        for (int i = 0; i < 8; ++i) { const size_t row = (size_t)ch * 64 + wave * 8 + i; ln_row(H1 + row * D, P.ln1_g, P.ln1_b, X1 + row * D, X1B + row * D, lane); }
        if (tid < 32) hist[tid] = 0u;
        VM_WAIT(); __syncthreads();
        const int rg = wave >> 2, kq = wave & 3;
        f32x16 acc;
#pragma unroll
        for (int i = 0; i < 16; ++i) acc[i] = 0.f;
        const float* xrow = X1 + ((size_t)ch * 64 + rg * 32 + (lane & 31)) * D + 4 * (lane >> 5);
        const float* wr = P.w_router + (size_t)(4 * (lane >> 5)) * NE + (lane & 31);
        for (int k0 = kq * 256; k0 < kq * 256 + 256; k0 += 8) {
            const f32x4 xa = *(const GAS f32x4*)(xrow + k0);
#pragma unroll
            for (int i = 0; i < 4; ++i) acc = __builtin_amdgcn_mfma_f32_32x32x2f32(xa[i], wr[(size_t)(k0 + i) * NE], acc, 0, 0, 0);
        }
#pragma unroll
        for (int i = 0; i < 16; ++i) part[(wave * 16 + i) * 64 + lane] = acc[i];
        __syncthreads();
        if (tid < 64) {
            const int r = tid, rgg = r >> 5, rho = r & 31, ii = (rho & 3) + 4 * (rho >> 3), lh = 32 * ((rho >> 2) & 1);
            float lg[NE];
#pragma unroll
            for (int e = 0; e < NE; ++e) { float s = P.b_router[e];
#pragma unroll
                for (int q = 0; q < 4; ++q) s += part[((rgg * 4 + q) * 16 + ii) * 64 + lh + e];
                lg[e] = s; }
            float tv[4]; int ti[4];
#pragma unroll
            for (int s = 0; s < 4; ++s) { float best = -INFINITY; int bi = 0;
#pragma unroll
                for (int e = 0; e < NE; ++e) if (lg[e] > best) { best = lg[e]; bi = e; }
                tv[s] = best; ti[s] = bi;
#pragma unroll
                for (int e = 0; e < NE; ++e) if (e == bi) lg[e] = -INFINITY; }
            const float e1 = __expf(tv[1] - tv[0]), e2 = __expf(tv[2] - tv[0]), e3 = __expf(tv[3] - tv[0]); const float inv = 1.0f / (1.0f + e1 + e2 + e3);
            const size_t row = (size_t)ch * 64 + r;
            *(int4*)(TOPI + row * 4) = make_int4(ti[0], ti[1], ti[2], ti[3]);
            *(float4*)(TOPG + row * 4) = make_float4(inv, e1 * inv, e2 * inv, e3 * inv);
#pragma unroll
            for (int s = 0; s < 4; ++s) atomicAdd((unsigned*)&hist[ti[s]], 1u);
        }
        __syncthreads();
        if (tid < 32) CNTCH[ch * 32 + tid] = (int)hist[tid];
        __syncthreads();
    }
}

__device__ __forceinline__ void ph_dispatch(const Ptrs& P, LAS unsigned char* lds, int G) {
    const int tid = threadIdx.x;
    const int* TOPI = (const int*)(P.ws + WS_TOPI); const float* TOPG = (const float*)(P.ws + WS_TOPG); const int* CNTCH = (const int*)(P.ws + WS_CNTCH);
    int* ROWTOK = (int*)(P.ws + WS_ROWTOK); float* ROWGATE = (float*)(P.ws + WS_ROWGATE); int* TOKPOS = (int*)(P.ws + WS_TOKPOS); int* EXPOFF = (int*)(P.ws + WS_EXPOFF);
    LAS int* redT = (LAS int*)lds;
    LAS int* redB = redT + 512;
    LAS int* offs = redB + 512;
    LAS int* tot = offs + 40;
    LAS int* bel = tot + 32;
    LAS int* el = bel + 32;
    for (int ch = blockIdx.x; ch < M / 64; ch += G) {
        { const int e = tid & 31, part = tid >> 5; int T = 0, B = 0;
            for (int c = part * 16; c < part * 16 + 16; ++c) { const int v = CNTCH[c * 32 + e]; T += v; if (c < ch) B += v; }
            redT[part * 32 + e] = T; redB[part * 32 + e] = B; }
        __syncthreads();
        if (tid < 32) { int T = 0, B = 0; for (int q = 0; q < 16; ++q) { T += redT[q * 32 + tid]; B += redB[q * 32 + tid]; } tot[tid] = T; bel[tid] = B; }
        __syncthreads();
        if (tid == 0) { int o = 0; for (int e = 0; e < NE; ++e) { offs[e] = o; o += (tot[e] + 255) & ~255; } offs[NE] = o; }
        if (tid < 256) el[tid] = TOPI[(size_t)ch * 256 + tid];
        __syncthreads();
        if (tid < 256) { const int e = el[tid]; int rank = 0; for (int j = 0; j < tid; ++j) rank += (el[j] == e) ? 1 : 0;
            const int pos = offs[e] + bel[e] + rank; const int row = ch * 64 + (tid >> 2);
            ROWTOK[pos] = row; ROWGATE[pos] = TOPG[(size_t)ch * 256 + tid]; TOKPOS[(size_t)ch * 256 + tid] = pos; }
        if (ch < NE) { const int e = ch; for (int r = offs[e] + tot[e] + tid; r < offs[e + 1]; r += 512) { ROWTOK[r] = 0; ROWGATE[r] = 0.f; } }
        if (ch == 0 && tid <= NE) EXPOFF[tid] = offs[tid];
        __syncthreads();
    }
}

__device__ __forceinline__ void ph_combine(const Ptrs& P, int G) {
    const int tid = threadIdx.x, lane = tid & 63, wave = __builtin_amdgcn_readfirstlane(tid >> 6);
    const float* X1 = (const float*)(P.ws + WS_X1); const bf16* Y = (const bf16*)(P.ws + WS_Y); const int* TOKPOS = (const int*)(P.ws + WS_TOKPOS);
    float* HH = (float*)(P.ws + WS_HH); bf16* HHB = (bf16*)(P.ws + WS_HHB);
    const int gw = blockIdx.x * NWAVES + wave, NGW = G * NWAVES;
    for (int t = gw; t < M; t += NGW) {
        const int4 pos = *(const int4*)(TOKPOS + (size_t)t * 4);
        const int pp[4] = {pos.x, pos.y, pos.z, pos.w};
#pragma unroll
        for (int j = 0; j < 4; ++j) { f32x4 h = ((const GAS f32x4*)(X1 + (size_t)t * D))[lane + 64 * j] * ALPHA;
#pragma unroll
            for (int s = 0; s < 4; ++s) { const v2u w = ((const GAS v2u*)(Y + (size_t)pp[s] * D))[lane + 64 * j]; h[0] += bflo(w.x); h[1] += bfhi(w.x); h[2] += bflo(w.y); h[3] += bfhi(w.y); }
            ((GAS f32x4*)(HH + (size_t)t * D))[lane + 64 * j] = h;
            v2u o; o.x = cvt_pk_bf16(h[0], h[1]); o.y = cvt_pk_bf16(h[2], h[3]); ((GAS v2u*)(HHB + (size_t)t * D))[lane + 64 * j] = o; }
    }
}

__device__ __forceinline__ void ph_ln2(const Ptrs& P, int G) {
    const int tid = threadIdx.x, lane = tid & 63, wave = __builtin_amdgcn_readfirstlane(tid >> 6);
    const float* V2 = (const float*)(P.ws + WS_V2);
    const int gw = blockIdx.x * NWAVES + wave, NGW = G * NWAVES;
    for (int t = gw; t < M; t += NGW) ln_row(V2 + (size_t)t * D, P.ln2_g, P.ln2_b, P.out + (size_t)t * D, nullptr, lane);
}

constexpr int NPHASE = 15;
struct Args { Ptrs p; int ph_lo, ph_hi; };
__global__ void __launch_bounds__(NWAVES * 64, 2) mk_fwd(Args args) {
    extern __shared__ __attribute__((aligned(16))) unsigned char lds_raw[];
    LAS unsigned char* lds = (LAS unsigned char*)lds_raw;
    volatile LAS unsigned* MISC = (volatile LAS unsigned*)(lds + MISC_OFF);
    const Ptrs& P = args.p; unsigned char* ws = P.ws;
    const int tid = threadIdx.x, G = gridDim.x;
    for (int u = tid; u < (LDS_BYTES - LDSCTL_OFF) / 4; u += NWAVES * 64) ((LAS unsigned*)(lds + LDSCTL_OFF))[u] = 0u;
    __syncthreads();
    const int lo = args.ph_lo, hi = args.ph_hi;
    const bool multi = (hi - lo) > 1;
    XcdBarrier bar; bar.bar = (unsigned*)(ws + WS_CTL) + CW_BAR; bar.x = 0; bar.st = nullptr;
    if (multi) bar = xcd_barrier_post((unsigned*)(ws + WS_CTL) + CW_BAR, MISC + 8);
#ifndef PH_MASK
#define PH_MASK 0x7fff
#endif
#define IN(k) ((((PH_MASK) >> (k)) & 1) && lo <= (k) && (k) < hi)
#define SEAM(k) do { if (IN(k) && IN((k) + 1)) xcd_barrier(bar); } while (0)
    LAS int* expoff = (LAS int*)(lds + LDSCTL_OFF);

    if (IN(0)) { ph_prologue(P, lds, G); SEAM(0); }
    if (IN(1)) {
        pg8::Gemm g{(const bf16*)(ws + WS_XB), (const bf16*)(ws + WS_WIN), M, NPROJ, D}; pg8::StaticOrder S; S.init(M, NPROJ, G, (int)blockIdx.x);
        EpiProj E{ws, (const float*)(ws + WS_BIASP)};
        pg8::gemm_phase<EpiProj, pg8::StaticOrder, true, true>(lds + RING_OFF, g, S, E);
        SEAM(1);
    }
    if (IN(2)) {
#ifndef NO_CONV
        ph_conv(P, lds, G); __syncthreads();
#endif
#ifndef NO_INDEX
#ifdef SLOW_INDEX
        ph_index_slow(P, lds, G);
#else
        ph_index_fast(P, lds, G);
#endif
#endif
        SEAM(2); }
    if (IN(3)) { ph_attn_slow(P, G); SEAM(3); }
    if (IN(4)) {
        pg8::Gemm g{(const bf16*)(ws + WS_AO), (const bf16*)(ws + WS_WOA), M, D, AW}; pg8::StaticOrder S; S.init(M, D, G, (int)blockIdx.x);
        EpiGated<false> E{(const bf16*)(ws + WS_SG), 0, nullptr, (bf16*)(ws + WS_T)};
        pg8::gemm_phase<EpiGated<false>, pg8::StaticOrder, true, true>(lds + RING_OFF, g, S, E);
        SEAM(4);
    }
    if (IN(5)) {
        pg8::Gemm g{(const bf16*)(ws + WS_CO), (const bf16*)(ws + WS_WOC), M, D, CCH}; pg8::StaticOrder S; S.init(M, D, G, (int)blockIdx.x);
        EpiGated<true> E{(const bf16*)(ws + WS_SG), 1024, (const bf16*)(ws + WS_T), (bf16*)(ws + WS_MG)};
        pg8::gemm_phase<EpiGated<true>, pg8::StaticOrder, true, true>(lds + RING_OFF, g, S, E);
        SEAM(5);
    }
    if (IN(6)) {
        pg8::Gemm g{(const bf16*)(ws + WS_MG), (const bf16*)(ws + WS_WOUT), M, D, D}; pg8::StaticOrder S; S.init(M, D, G, (int)blockIdx.x);
        EpiRes E{P.x, (float*)(ws + WS_H1)};
        pg8::gemm_phase<EpiRes, pg8::StaticOrder, true, true>(lds + RING_OFF, g, S, E);
        SEAM(6);
    }
    if (IN(7)) { ph_ln1_router(P, lds, G); SEAM(7); }
    if (IN(8)) { ph_dispatch(P, lds, G); SEAM(8); }
    if (IN(9) || IN(10)) { if (tid <= NE) expoff[tid] = ((const int*)(ws + WS_EXPOFF))[tid]; __syncthreads(); }
    if (IN(9)) {
        pg8::Gemm g{(const bf16*)(ws + WS_X1B), (const bf16*)(ws + WS_WGU), RMAX, 2 * DE, D};
        MoeOrder<true> S{expoff, 8, G, (int)blockIdx.x, (const int*)(ws + WS_ROWTOK), D, (size_t)2 * DE * D * 2};
        EpiSwiglu E{(const float*)(ws + WS_BGUP), (bf16*)(ws + WS_HB)};
        pg8::gemm_phase<EpiSwiglu, MoeOrder<true>, true, true>(lds + RING_OFF, g, S, E);
        SEAM(9);
    }
    if (IN(10)) {
        pg8::Gemm g{(const bf16*)(ws + WS_HB), (const bf16*)(ws + WS_WD), RMAX, D, DE};
        MoeOrder<false> S{expoff, 4, G, (int)blockIdx.x, nullptr, DE, (size_t)D * DE * 2};
        EpiDown E{P.b_down, (const float*)(ws + WS_ROWGATE), (bf16*)(ws + WS_Y)};
        pg8::gemm_phase<EpiDown, MoeOrder<false>, true, true>(lds + RING_OFF, g, S, E);
        SEAM(10);
    }
    if (IN(11)) { ph_combine(P, G); SEAM(11); }
    if (IN(12)) {
        pg8::Gemm g{(const bf16*)(ws + WS_PB), (const bf16*)(ws + WS_WPP), M, D, PLE}; pg8::StaticOrder S; S.init(M, D, G, (int)blockIdx.x);
        EpiPlain E{(bf16*)(ws + WS_PP)};
        pg8::gemm_phase<EpiPlain, pg8::StaticOrder, true, true>(lds + RING_OFF, g, S, E);
        SEAM(12);
    }
    if (IN(13)) {
        pg8::Gemm g{(const bf16*)(ws + WS_HHB), (const bf16*)(ws + WS_WPG), M, D, D}; pg8::StaticOrder S; S.init(M, D, G, (int)blockIdx.x);
        EpiPle E{(const float*)(ws + WS_HH), (const bf16*)(ws + WS_PP), (float*)(ws + WS_V2)};
        pg8::gemm_phase<EpiPle, pg8::StaticOrder, true, true>(lds + RING_OFF, g, S, E);
        SEAM(13);
    }
    if (IN(14)) { ph_ln2(P, G); }
#ifdef DBG_OUT
    if (lo == 15) {
        const size_t gt = (size_t)blockIdx.x * (NWAVES * 64) + tid, NT = (size_t)G * NWAVES * 64;
        for (size_t i = gt; i < (size_t)M * D; i += NT) {
#if DBG_OUT == 1
            P.out[i] = ((const float*)(ws + WS_H1))[i];
#elif DBG_OUT == 2
            P.out[i] = bf2f(((const bf16*)(ws + WS_MG))[i]);
#elif DBG_OUT == 3
            { const size_t r = i >> 10, c = i & 1023; P.out[i] = c < 512 ? bf2f(((const bf16*)(ws + WS_AO))[r * 512 + c]) : bf2f(((const bf16*)(ws + WS_CO))[r * 512 + c - 512]); }
#elif DBG_OUT == 4
            { const size_t r = i >> 10, c = i & 1023; P.out[i] = c < 512 ? (float)(((const unsigned*)(ws + WS_MASK))[r * 512 + c] & 0xffffu) : (float)(((const unsigned*)(ws + WS_MASK))[r * 512 + c - 512] >> 16); }
#elif DBG_OUT == 5
            P.out[i] = ((const float*)(ws + WS_HH))[i];
#elif DBG_OUT == 6
            P.out[i] = ((const float*)(ws + WS_X1))[i];
#elif DBG_OUT == 7
            P.out[i] = bf2f(((const bf16*)(ws + WS_T))[i]);
#elif DBG_OUT == 9
            { const size_t r = i >> 10, c = i & 1023; P.out[i] = c < 512 ? bf2f(((const bf16*)(ws + WS_Q))[r * 512 + c]) : bf2f(((const bf16*)(ws + WS_U))[r * 512 + c - 512]); }
#elif DBG_OUT == 10
            { const size_t r = i >> 10, c = i & 1023; P.out[i] = bf2f(((const bf16*)(ws + WS_WIN))[(3072 + (r & 2047)) * 1024 + c]) + ((const float*)(ws + WS_BIASP))[3072 + (i & 2047)]; }
#elif DBG_OUT == 8
            { const size_t r = i >> 10, c = i & 1023; P.out[i] = bf2f(((const bf16*)(ws + WS_SG))[r * 2048 + c]) + 2.f * bf2f(((const bf16*)(ws + WS_SG))[r * 2048 + 1024 + c]); }
#endif
        }
    }
#endif
#undef IN
#undef SEAM
}

#ifndef MK_ONE_LAUNCH
#define MK_ONE_LAUNCH 1
#endif
extern "C" void kernel_launch(void* const* d_in, const int* in_sizes, int n_in, void* d_out, int out_size, void* d_ws, size_t ws_size, hipStream_t stream) {
    static int grid = 0;
    if (grid == 0) {
        if (n_in != 24 || in_sizes[0] != M * D || out_size != M * D || ws_size < WS_END) { fprintf(stderr, "kernel_launch: unexpected shapes (n_in %d, in0 %d, out %d, ws %zu)\n", n_in, n_in > 0 ? in_sizes[0] : -1, out_size, ws_size); grid = -1; return; }
        int dev = 0, cus = 0, per_cu = 0;
        if (hipGetDevice(&dev) != hipSuccess || hipDeviceGetAttribute(&cus, hipDeviceAttributeMultiprocessorCount, dev) != hipSuccess) { grid = -1; return; }
        if (hipFuncSetAttribute((const void*)mk_fwd, hipFuncAttributeMaxDynamicSharedMemorySize, LDS_BYTES) != hipSuccess) { fprintf(stderr, "kernel_launch: hipFuncSetAttribute failed\n"); grid = -1; return; }
        if (hipOccupancyMaxActiveBlocksPerMultiprocessor(&per_cu, (const void*)mk_fwd, NWAVES * 64, LDS_BYTES) != hipSuccess || per_cu < 1) fprintf(stderr, "kernel_launch: occupancy query reports %d\n", per_cu);
        (void)hipGetLastError();
        grid = cus;
    }
    if (grid < 0) return;
    if (hipMemsetAsync((char*)d_ws + WS_CTL, 0, CTL_ZERO_BYTES, stream) != hipSuccess) return;
    Args a{};
    const float** pp = (const float**)&a.p;
    for (int i = 0; i < 24; ++i) pp[i] = (const float*)d_in[i];
    a.p.out = (float*)d_out; a.p.ws = (unsigned char*)d_ws;
#if MK_ONE_LAUNCH
    a.ph_lo = 0; a.ph_hi = NPHASE;
    hipLaunchKernelGGL(mk_fwd, dim3(grid), dim3(NWAVES * 64), LDS_BYTES, stream, a);
#else
#ifndef NRUN
#define NRUN NPHASE
#endif
#ifdef DBG_OUT
    for (int ph = 0; ph <= (DBG_OUT <= 4 ? (DBG_OUT == 1 ? 6 : DBG_OUT == 2 ? 5 : 3) : (DBG_OUT == 5 ? 11 : DBG_OUT == 6 ? 7 : DBG_OUT == 7 ? 4 : 1)); ++ph) { a.ph_lo = ph; a.ph_hi = ph + 1; hipLaunchKernelGGL(mk_fwd, dim3(grid), dim3(NWAVES * 64), LDS_BYTES, stream, a); }
    a.ph_lo = 15; a.ph_hi = 16; hipLaunchKernelGGL(mk_fwd, dim3(grid), dim3(NWAVES * 64), LDS_BYTES, stream, a);
    return;
#endif
    for (int ph = 0; ph < NRUN; ++ph) { a.ph_lo = ph; a.ph_hi = ph + 1; hipLaunchKernelGGL(mk_fwd, dim3(grid), dim3(NWAVES * 64), LDS_BYTES, stream, a); }
#endif
}
```

```cpp
#include <hip/hip_runtime.h>
#include <cstdio>
#include <cstdint>

namespace pg8 {
#define PG8_LAS __attribute__((address_space(3)))
typedef unsigned short bf16_t;
typedef short bf16x8 __attribute__((ext_vector_type(8)));
typedef float f32x4 __attribute__((ext_vector_type(4)));
typedef unsigned u32x4 __attribute__((ext_vector_type(4)));
typedef unsigned u32x2 __attribute__((ext_vector_type(2)));
constexpr int BM = 256, BK = 64, HALF = 128, HTB = HALF * BK * 2  , STAGE_BYTES = 8 * HTB, NXCD = 8, WGM = 8;

__host__ __device__ __forceinline__ int lds_byte(int r, int c) { const int st = (r >> 4) * 2 + (c >> 5), rr = r & 15, cc = c & 31, ob = rr * 64 + cc * 2; return st * 1024 + (ob ^ (((ob >> 9) & 1) << 5)); }
__host__ __device__ __forceinline__ void stage_rc(int b, int& R, int& C) { const int st = b / 1024, sb = b % 1024, swz = sb ^ (((sb >> 9) & 1) << 5); R = (st >> 1) * 16 + swz / 64; C = (st & 1) * 32 + (swz % 64) / 2; }
__host__ __device__ __forceinline__ int perm32(int rho) { const int n = rho >> 4, i = rho & 15; return 8 * (i >> 2) + 4 * n + (i & 3); }

struct Unit { int pm, pn, e; };
struct Gemm { const bf16_t* A; const bf16_t* Bt; int M, N, K; };

struct StaticOrder {
    static constexpr bool GATHER = false;
    int nM, nN, nwg, G, c;
    __host__ __device__ void init(int M, int N, int G_, int c_) { nM = M / BM; nN = N / BM; nwg = nM * nN; G = G_; c = c_; }
    __host__ __device__ bool next(int i, Unit& u) const {
        const long L = (long)i * G + c; if (L >= nwg) return false;
        int wgid = (int)L; { const int q = nwg / NXCD, r = nwg % NXCD, xcd = wgid % NXCD, off = wgid / NXCD; wgid = (xcd < r ? xcd * (q + 1) : r * (q + 1) + (xcd - r) * q) + off; }
        const int nig = WGM * nN, gid = wgid / nig, fm = gid * WGM, gsz = (nM - fm) < WGM ? (nM - fm) : WGM;
        u.pm = fm + ((wgid % nig) % gsz); u.pn = (wgid % nig) / gsz; u.e = 0; return true;
    }
    __device__ __forceinline__ const char* a_base(const Gemm& g, const Unit& u) const { return (const char*)g.A + (size_t)u.pm * ((size_t)BM * g.K * 2); }
    __device__ __forceinline__ const char* b_base(const Gemm& g, const Unit& u) const { return (const char*)g.Bt + (size_t)u.pn * ((size_t)BM * g.K * 2); }
    __device__ __forceinline__ unsigned a_rowoff(const Unit&, int, int) const { return 0u; }
};

typedef float f32x2_cv __attribute__((ext_vector_type(2))); typedef __bf16 bf16x2_cv __attribute__((ext_vector_type(2)));
__device__ __forceinline__ unsigned cvt_pk_bf16(float lo, float hi) { const f32x2_cv v = {lo, hi}; const bf16x2_cv b = __builtin_convertvector(v, bf16x2_cv); return __builtin_bit_cast(unsigned, b); }

template <class Epi, class Sched, bool ALIGN_EPI = false, bool SP2 = false>
__device__ __forceinline__ void gemm_phase(PG8_LAS unsigned char* lds, const Gemm g, const Sched& S, const Epi& E) {
    const int tid = threadIdx.x, wid = __builtin_amdgcn_readfirstlane(tid >> 6), lane = tid & 63, wr = wid >> 2, wc = wid & 3, fr = lane & 15, fq = lane >> 4;
    int K_ = g.K; asm volatile("" : "+s"(K_));
    const int K = K_, nt = K / BK;
    constexpr bool GATHER = Sched::GATHER;
    int Rr[2], Cc[2]; unsigned voffB[2];
#pragma unroll
    for (int i = 0; i < 2; ++i) { stage_rc(tid * 16 + i * 8192, Rr[i], Cc[i]); const int Rb = Epi::PERM ? ((Rr[i] & ~31) + perm32(Rr[i] & 31)) : Rr[i];
        voffB[i] = (unsigned)(Rb * K + Cc[i]) * 2u; }
    const size_t kstep = (size_t)(BK * 2);
    const size_t hstep = (size_t)HALF * K * 2;
    const unsigned ldsw = (unsigned)wid * 1024u;
    const int aoff = lds_byte(wr * 64 + fr, fq * 8), boff = lds_byte(wc * 32 + fr, fq * 8);
    unsigned vA[2][2], vN[2][2];
#define PG8_SETA(v, u) do { _Pragma("unroll") for (int _h = 0; _h < 2; ++_h) _Pragma("unroll") for (int _i = 0; _i < 2; ++_i) \
        v[_h][_i] = (GATHER ? S.a_rowoff(u, _h, Rr[_i]) : (unsigned)((_h * HALF + Rr[_i]) * K) * 2u) + (unsigned)Cc[_i] * 2u; } while (0)
#define PG8_SA(b, h) (((b) * 2 + (h)) * HTB)
#define PG8_SB(b, h) ((4 + (b) * 2 + (h)) * HTB)
#define PG8_STAGE(bufoff, gbase, voff) do { _Pragma("unroll") for (int _i = 0; _i < 2; ++_i) \
        __builtin_amdgcn_global_load_lds((const unsigned*)((const char*)(gbase) + (voff)[_i]), (PG8_LAS unsigned*)(lds + (bufoff) + ldsw + _i * 8192), 16, 0, 0); } while (0)
#define PG8_LDA(dst, b, h) do { _Pragma("unroll") for (int m = 0; m < 4; ++m) _Pragma("unroll") for (int k = 0; k < 2; ++k) dst[m][k] = *(const PG8_LAS bf16x8*)(lds + PG8_SA(b, h) + aoff + m * 2048 + k * 1024); } while (0)
#define PG8_LDB(dst, b, h) do { _Pragma("unroll") for (int n = 0; n < 2; ++n) _Pragma("unroll") for (int k = 0; k < 2; ++k) dst[n][k] = *(const PG8_LAS bf16x8*)(lds + PG8_SB(b, h) + boff + n * 2048 + k * 1024); } while (0)
#define PG8_MMA(ai, bj, At, Bt) do { __builtin_amdgcn_s_setprio(1); _Pragma("unroll") for (int m = 0; m < 4; ++m) _Pragma("unroll") for (int n = 0; n < 2; ++n) _Pragma("unroll") for (int k = 0; k < 2; ++k) \
        acc[ai][bj][m][n] = __builtin_amdgcn_mfma_f32_16x16x32_bf16(Bt[n][k], At[m][k], acc[ai][bj][m][n], 0, 0, 0); __builtin_amdgcn_s_setprio(0); } while (0)
#define PG8_WAIT_V(n) asm volatile("s_waitcnt vmcnt(" #n ")" ::: "memory")
#define PG8_WAIT_L(n) asm volatile("s_waitcnt lgkmcnt(" #n ")" ::: "memory")
#define PG8_BAR __builtin_amdgcn_s_barrier()
#define PG8_SCHED __builtin_amdgcn_sched_barrier(0)
    Unit cur, nxt; int ui = 0;
    if (!S.next(0, cur)) return;
    f32x4 acc[2][2][4][2];
#pragma unroll
    for (int a = 0; a < 2; ++a)
#pragma unroll
        for (int b = 0; b < 2; ++b)
#pragma unroll
            for (int m = 0; m < 4; ++m)
#pragma unroll
                for (int n = 0; n < 2; ++n) acc[a][b][m][n] = (f32x4){0.f, 0.f, 0.f, 0.f};
    bf16x8 At[4][2], B0[2][2], B1[2][2];
    const char* cA = S.a_base(g, cur); const char* cB = S.b_base(g, cur);
    PG8_SETA(vA, cur);
    if constexpr (GATHER) { asm volatile("s_waitcnt vmcnt(0)" ::: "memory"); asm volatile("" : "+v"(vA[0][0]), "+v"(vA[0][1]), "+v"(vA[1][0]), "+v"(vA[1][1])); }
    if constexpr (SP2) {
        PG8_STAGE(PG8_SB(0, 0), cB, voffB); PG8_STAGE(PG8_SB(0, 1), cB + hstep, voffB); PG8_STAGE(PG8_SA(0, 0), cA, vA[0]); PG8_STAGE(PG8_SA(0, 1), cA, vA[1]);
        if (wr == 1) PG8_BAR;
        PG8_WAIT_V(2); PG8_BAR;
        PG8_STAGE(PG8_SB(1, 0), cB + kstep, voffB); PG8_STAGE(PG8_SA(1, 0), cA + kstep, vA[0]); PG8_STAGE(PG8_SB(1, 1), cB + hstep + kstep, voffB);
        PG8_WAIT_V(6); PG8_BAR;
    } else {
        PG8_STAGE(PG8_SB(0, 0), cB, voffB); PG8_STAGE(PG8_SA(0, 0), cA, vA[0]); PG8_STAGE(PG8_SB(0, 1), cB + hstep, voffB); PG8_STAGE(PG8_SA(0, 1), cA, vA[1]);
        if (wr == 1) PG8_BAR;
        PG8_WAIT_V(4); PG8_BAR;
        PG8_STAGE(PG8_SB(1, 0), cB + kstep, voffB); PG8_STAGE(PG8_SA(1, 0), cA + kstep, vA[0]); PG8_STAGE(PG8_SB(1, 1), cB + hstep + kstep, voffB);
        PG8_WAIT_V(6); PG8_BAR;
    }
    for (;;) {
        const bool has_next = S.next(ui + 1, nxt);
        const char* nA = has_next ? S.a_base(g, nxt) : cA; const char* nB = has_next ? S.b_base(g, nxt) : cB;
        if constexpr (GATHER) {
            if (has_next) { PG8_SETA(vN, nxt); asm volatile("s_waitcnt vmcnt(0)" ::: "memory"); asm volatile("" : "+v"(vN[0][0]), "+v"(vN[0][1]), "+v"(vN[1][0]), "+v"(vN[1][1])); }
            else {
#pragma unroll
                for (int _h = 0; _h < 2; ++_h)
#pragma unroll
                    for (int _i = 0; _i < 2; ++_i) vN[_h][_i] = vA[_h][_i]; }
        }
        for (int t = 0; t < nt; t += 2) {
            const bool last = (t == nt - 2);
            const char* a1 = cA + (size_t)(t + 1) * kstep;
            const char* a2 = last ? nA : cA + (size_t)(t + 2) * kstep; const char* b2 = last ? nB : cB + (size_t)(t + 2) * kstep;
            const char* a3 = a2 + kstep; const char* b3 = b2 + kstep;
            unsigned wA[2][2];
#pragma unroll
            for (int _h = 0; _h < 2; ++_h)
#pragma unroll
                for (int _i = 0; _i < 2; ++_i) wA[_h][_i] = GATHER ? (last ? vN[_h][_i] : vA[_h][_i]) : vA[_h][_i];
            if constexpr (SP2) {
            PG8_LDB(B0, 0, 0); PG8_LDB(B1, 0, 1); PG8_SCHED; PG8_LDA(At, 0, 0); PG8_STAGE(PG8_SA(1, 1), a1, vA[1]);
            PG8_WAIT_V(8); PG8_WAIT_L(0); PG8_BAR; PG8_MMA(0, 0, At, B0); PG8_MMA(0, 1, At, B1); PG8_BAR; PG8_SCHED;
            PG8_LDA(At, 0, 1); PG8_STAGE(PG8_SB(0, 0), b2, voffB); PG8_STAGE(PG8_SB(0, 1), b2 + hstep, voffB); PG8_STAGE(PG8_SA(0, 0), a2, wA[0]);
            PG8_WAIT_V(8); PG8_WAIT_L(0); PG8_BAR; PG8_MMA(1, 0, At, B0); PG8_MMA(1, 1, At, B1); PG8_BAR; PG8_SCHED;
            PG8_LDB(B0, 1, 0); PG8_LDB(B1, 1, 1); PG8_SCHED; PG8_LDA(At, 1, 0); PG8_STAGE(PG8_SA(0, 1), a2, wA[1]);
            PG8_WAIT_V(8); PG8_WAIT_L(0); PG8_BAR; PG8_MMA(0, 0, At, B0); PG8_MMA(0, 1, At, B1); PG8_BAR; PG8_SCHED;
            PG8_LDA(At, 1, 1); PG8_STAGE(PG8_SB(1, 0), b3, voffB); PG8_STAGE(PG8_SB(1, 1), b3 + hstep, voffB); PG8_STAGE(PG8_SA(1, 0), a3, wA[0]);
            PG8_WAIT_V(8); PG8_WAIT_L(0); PG8_BAR; PG8_MMA(1, 0, At, B0); PG8_MMA(1, 1, At, B1); PG8_BAR; PG8_SCHED;
            } else {
            PG8_LDB(B0, 0, 0); PG8_SCHED; PG8_LDA(At, 0, 0); PG8_STAGE(PG8_SA(1, 1), a1, vA[1]);
            PG8_WAIT_L(8); PG8_BAR; PG8_WAIT_L(0); PG8_MMA(0, 0, At, B0); PG8_BAR; PG8_SCHED;
            PG8_LDB(B1, 0, 1); PG8_STAGE(PG8_SB(0, 0), b2, voffB);
            PG8_BAR; PG8_WAIT_L(0); PG8_MMA(0, 1, At, B1); PG8_BAR;
            PG8_LDA(At, 0, 1); PG8_STAGE(PG8_SA(0, 0), a2, wA[0]);
            PG8_BAR; PG8_WAIT_L(0); PG8_MMA(1, 0, At, B0); PG8_BAR; PG8_SCHED;
            PG8_STAGE(PG8_SB(0, 1), b2 + hstep, voffB);
            PG8_WAIT_V(6); PG8_BAR; PG8_MMA(1, 1, At, B1); PG8_BAR;
            PG8_LDB(B0, 1, 0); PG8_SCHED; PG8_LDA(At, 1, 0); PG8_STAGE(PG8_SA(0, 1), a2, wA[1]);
            PG8_WAIT_L(8); PG8_BAR; PG8_WAIT_L(0); PG8_MMA(0, 0, At, B0); PG8_BAR; PG8_SCHED;
            PG8_LDB(B1, 1, 1); PG8_STAGE(PG8_SB(1, 0), b3, voffB);
            PG8_BAR; PG8_WAIT_L(0); PG8_MMA(0, 1, At, B1); PG8_BAR;
            PG8_LDA(At, 1, 1); PG8_STAGE(PG8_SA(1, 0), a3, wA[0]);
            PG8_BAR; PG8_WAIT_L(0); PG8_MMA(1, 0, At, B0); PG8_BAR; PG8_SCHED;
            PG8_STAGE(PG8_SB(1, 1), b3 + hstep, voffB);
            PG8_WAIT_V(6); PG8_BAR; PG8_MMA(1, 1, At, B1); PG8_BAR;
            }
        }
        if constexpr (ALIGN_EPI) { if (wr == 0) PG8_BAR; }
        E(acc, cur, wr, wc, fr, fq);
        if (!has_next) break;
#pragma unroll
        for (int a = 0; a < 2; ++a)
#pragma unroll
            for (int b = 0; b < 2; ++b)
#pragma unroll
                for (int m = 0; m < 4; ++m)
#pragma unroll
                    for (int n = 0; n < 2; ++n) acc[a][b][m][n] = (f32x4){0.f, 0.f, 0.f, 0.f};
        cur = nxt; cA = nA; cB = nB; ++ui;
#pragma unroll
        for (int _h = 0; _h < 2; ++_h)
#pragma unroll
            for (int _i = 0; _i < 2; ++_i) vA[_h][_i] = GATHER ? vN[_h][_i] : vA[_h][_i];
        if constexpr (ALIGN_EPI) { if (wr == 1) PG8_BAR; }
    }
    PG8_WAIT_V(0);
    if constexpr (!ALIGN_EPI) { if (wr == 0) PG8_BAR; }
    PG8_BAR;
#undef PG8_SETA
#undef PG8_SA
#undef PG8_SB
#undef PG8_STAGE
#undef PG8_LDA
#undef PG8_LDB
#undef PG8_MMA
#undef PG8_WAIT_V
#undef PG8_WAIT_L
#undef PG8_BAR
#undef PG8_SCHED
}
}

constexpr int NWAVES = 8;
constexpr int M = 16384, D = 1024, AW = 512, NH = 8, HD = 64, CCH = 512, CWID = 31, NE = 32, DE = 1024, PLE = 256;
constexpr int IN_COLS = 5192, NPROJ = 5376;
constexpr float LN_EPS = 1e-5f;
constexpr float ALPHA = 1.18920711500272f;
constexpr float LOG2E = 1.4426950408889634f;
constexpr float C2 = 0.125f * LOG2E;
constexpr int RMAX = 73728;
constexpr int TOPK = 256;

constexpr size_t MiB = 1u << 20;
constexpr size_t WS_CTL = 0, CTL_ZERO_BYTES = 1 * MiB;
constexpr size_t WS_SMALL = 1 * MiB;
constexpr size_t WS_BIASP = WS_SMALL;
constexpr size_t WS_BGUP = WS_SMALL + 32 * 1024;
constexpr size_t WS_RT = WS_SMALL + 320 * 1024;
constexpr size_t WS_EXPOFF = WS_SMALL + 328 * 1024;
constexpr size_t WS_CNTCH = WS_SMALL + 332 * 1024;
constexpr size_t WS_WIN = 2 * MiB;
constexpr size_t WS_WOA = 13 * MiB, WS_WOC = 14 * MiB, WS_WOUT = 15 * MiB, WS_WPG = 17 * MiB, WS_WPP = 19 * MiB;
constexpr size_t WS_WGU = 20 * MiB;
constexpr size_t WS_WD = 148 * MiB;
constexpr size_t WS_XB = 212 * MiB;
constexpr size_t WS_Q = 252 * MiB, WS_K = 268 * MiB, WS_V = 284 * MiB, WS_QI = 300 * MiB;
constexpr size_t WS_KI = 316 * MiB;
constexpr size_t WS_WI = 318 * MiB;
constexpr size_t WS_U = 319 * MiB;
constexpr size_t WS_SG = 335 * MiB;
constexpr size_t WS_MASK = 399 * MiB;
constexpr size_t WS_AO = 431 * MiB, WS_CO = 447 * MiB;
constexpr size_t WS_T = 463 * MiB, WS_MG = 495 * MiB;
constexpr size_t WS_H1 = 527 * MiB;
constexpr size_t WS_X1 = 591 * MiB;
constexpr size_t WS_X1B = 655 * MiB;
constexpr size_t WS_ROUTE = 687 * MiB;
constexpr size_t WS_TOPI = WS_ROUTE, WS_TOPG = WS_ROUTE + 256 * 1024, WS_TOKPOS = WS_ROUTE + 512 * 1024, WS_ROWTOK = WS_ROUTE + 768 * 1024, WS_ROWGATE = WS_ROUTE + 1088 * 1024;
constexpr size_t WS_PP = 689 * MiB;
constexpr size_t WS_PB = 721 * MiB;
constexpr size_t WS_END = 729 * MiB;
constexpr size_t WS_HB = 212 * MiB;
constexpr size_t WS_Y = 356 * MiB;
constexpr size_t WS_HH = WS_H1;
constexpr size_t WS_HHB = WS_X1B;
constexpr size_t WS_V2 = WS_X1;
static_assert(WS_HB + (size_t)RMAX * 1024 * 2 <= WS_Y && WS_Y + (size_t)RMAX * 1024 * 2 <= WS_H1, "overlay map");
static_assert(WS_ROWGATE + RMAX * 4 <= WS_PP, "route map");

constexpr int CW_TMO = 0;
constexpr int CW_BAR = 4096;

constexpr int RING_OFF = 0, RING_BYTES = 131072;
constexpr int LDSCTL_OFF = RING_BYTES, MISC_OFF = LDSCTL_OFF + 320;
constexpr int LDS_BYTES = 147456;
static_assert(MISC_OFF + 128 <= LDS_BYTES, "LDS map");

#define GAS __attribute__((address_space(1)))
#define LAS __attribute__((address_space(3)))
typedef unsigned short bf16;
typedef unsigned v4u __attribute__((ext_vector_type(4)));
typedef unsigned v2u __attribute__((ext_vector_type(2)));
typedef float f32x4 __attribute__((ext_vector_type(4)));
typedef float f32x16 __attribute__((ext_vector_type(16)));
typedef short bf16x8 __attribute__((ext_vector_type(8)));
typedef GAS unsigned gu32;
typedef GAS unsigned long long gu64;
#define RLX_AGENT __ATOMIC_RELAXED, __HIP_MEMORY_SCOPE_AGENT
#define LDS_WAIT() asm volatile("s_waitcnt lgkmcnt(0)" ::: "memory")
#define VM_WAIT() asm volatile("s_waitcnt vmcnt(0)" ::: "memory")
__device__ __forceinline__ unsigned f2bf(float f) { unsigned u = __builtin_bit_cast(unsigned, f); return (u + 0x7fffu + ((u >> 16) & 1u)) >> 16; }
__device__ __forceinline__ float bf2f(unsigned b) { return __builtin_bit_cast(float, b << 16); }
__device__ __forceinline__ float bflo(unsigned w) { return __builtin_bit_cast(float, w << 16); }
__device__ __forceinline__ float bfhi(unsigned w) { return __builtin_bit_cast(float, w & 0xffff0000u); }
__device__ __forceinline__ float sigmoidf_(float x) { return __builtin_amdgcn_rcpf(1.0f + __builtin_amdgcn_exp2f(-LOG2E * x)); }
__device__ __forceinline__ LAS unsigned char* lds_opaque(LAS unsigned char* p) { unsigned a = (unsigned)(unsigned long)p; asm volatile("" : "+v"(a)); return (LAS unsigned char*)(unsigned long)a; }
__device__ __forceinline__ unsigned pk2(float lo, float hi) { return f2bf(lo) | (f2bf(hi) << 16); }

#define XB_TMO      128
#define XB_XCNT(j)  (256  + 64 * (j))
#define XB_XSUB(j)  (1280 + 64 * (j))
#define XB_XGEN(j)  (2304 + 64 * (j))
#define XB_TOP      3328
#define XB_TOPGEN   3392
#define XCD_BAR_WORDS 3456
#define XB_SPIN_CAP (1u << 18)

__device__ __forceinline__ unsigned xb_ld(unsigned* p)              { return __hip_atomic_load(p, __ATOMIC_RELAXED, __HIP_MEMORY_SCOPE_AGENT); }
__device__ __forceinline__ unsigned xb_add(unsigned* p, unsigned v) { return __hip_atomic_fetch_add(p, v, __ATOMIC_RELAXED, __HIP_MEMORY_SCOPE_AGENT); }
__device__ __forceinline__ unsigned xb_xcc_id() { return (unsigned)__builtin_amdgcn_s_getreg((3 << 11) | 20) & 0xFu; }
#define XB_SPIN(cond, bar) do { unsigned _sp = 0; while (cond) { __builtin_amdgcn_s_sleep(1); \
    if ((++_sp & 255u) == 0u) { if (xb_ld(&(bar)[XB_TMO])) break; if (_sp > XB_SPIN_CAP) { atomicAdd(&(bar)[XB_TMO], 1u); break; } } } } while (0)

struct XcdBarrier {
    unsigned* bar; unsigned x;
    volatile LAS unsigned* st;
};

__device__ __forceinline__ XcdBarrier xcd_barrier_post(unsigned* bar, volatile LAS unsigned* st) {
    XcdBarrier b; b.bar = bar; b.x = xb_xcc_id(); b.st = st;
    if (threadIdx.x == 0) (void)xb_add(&bar[XB_XCNT(b.x)], 1u);
    return b;
}
__device__ __forceinline__ void xcd_barrier_complete(unsigned* bar, unsigned x, unsigned& nloc, unsigned& nx) {
    const unsigned G = gridDim.x * gridDim.y * gridDim.z;
    unsigned sum, cnt, mine, sp = 0u;
    for (;;) {
        sum = 0u; cnt = 0u; mine = 0u;
#pragma unroll
        for (unsigned j = 0; j < 16; ++j) { const unsigned c = xb_ld(&bar[XB_XCNT(j)]); sum += c; cnt += (c > 0u) ? 1u : 0u; mine = (j == x) ? c : mine; }
        if (sum == G) break;
        __builtin_amdgcn_s_sleep(1);
        if ((++sp & 255u) == 0u) { if (xb_ld(&bar[XB_TMO])) break; if (sp > XB_SPIN_CAP) { atomicAdd(&bar[XB_TMO], 1u); break; } }
    }
    nloc = mine > 0u ? mine : 1u; nx = cnt > 0u ? cnt : 1u;
}

__device__ __forceinline__ void xcd_barrier(const XcdBarrier& b) {
    asm volatile("s_waitcnt vmcnt(0)" ::: "memory");
    __syncthreads();
    if (threadIdx.x == 0) {
        unsigned* bar = b.bar;
        __builtin_amdgcn_s_waitcnt(0);
        unsigned nloc = b.st[0], nx = b.st[1];
        if (nloc == 0u) { xcd_barrier_complete(bar, b.x, nloc, nx); b.st[0] = nloc; b.st[1] = nx; }
        const unsigned old = xb_add(&bar[XB_XSUB(b.x)], 1u);
        const unsigned gen = old / nloc;
        if (old + 1u == (gen + 1u) * nloc) {
            __builtin_amdgcn_fence(__ATOMIC_RELEASE, "agent");
            asm volatile("s_waitcnt vmcnt(0)" ::: "memory");
            const unsigned og = xb_add(&bar[XB_TOP], 1u);
            const unsigned tg = og / nx;
            if (og + 1u == (tg + 1u) * nx) xb_add(&bar[XB_TOPGEN], 1u);
            else XB_SPIN(xb_ld(&bar[XB_TOPGEN]) == tg, bar);
            __builtin_amdgcn_fence(__ATOMIC_ACQUIRE, "agent");
            xb_add(&bar[XB_XGEN(b.x)], 1u);
            asm volatile("s_waitcnt vmcnt(0)" ::: "memory");
        } else {
            XB_SPIN(xb_ld(&bar[XB_XGEN(b.x)]) == gen, bar);
            __builtin_amdgcn_fence(__ATOMIC_ACQUIRE, "agent");
            asm volatile("s_waitcnt vmcnt(0)" ::: "memory");
        }
    }
    __syncthreads();
}


__device__ __forceinline__ float wave_sum(float v) {
#pragma unroll
    for (int o = 1; o < 64; o <<= 1) v += __shfl_xor(v, o);
    return v;
}
__device__ __forceinline__ unsigned f2key(float f) { const unsigned u = __builtin_bit_cast(unsigned, f); return (u & 0x80000000u) ? ~u : (u | 0x80000000u); }
__device__ __forceinline__ int map_in(int n) {
    if (n < 2048) return n;
    if (n < 2112) return 5120 + (n - 2048);
    if (n < 2120) return 5184 + (n - 2112);
    if (n < 2632) { const int c = n - 2120; return 2048 + 8 * (c >> 2) + (c & 3); }
    if (n < 3144) { const int c = n - 2632; return 2048 + 8 * (c >> 2) + 4 + (c & 3); }
    return 3072 + (n - 3144);
}
__device__ __forceinline__ int map_gu(int n) { const int c = n & 1023; return 8 * (c >> 2) + ((n >> 10) << 2) + (c & 3); }
__device__ __forceinline__ int map_id(int n) { return n; }

template <class MapF>
__device__ __forceinline__ void transpose_item(const float* W, int K, int N, bf16* WT, LAS float* scr, int item, int lane, MapF map) {
    const int nblk = (N + 31) / 32, kb = item / nblk, nb = item % nblk, k0 = 64 * kb, n0 = 32 * nb;
    const int nn = n0 + (lane & 31);
#pragma unroll 8
    for (int i = 0; i < 32; ++i) { const int kk = 2 * i + (lane >> 5); scr[kk * 33 + (lane & 31)] = nn < N ? W[(size_t)(k0 + kk) * N + nn] : 0.f; }
    LDS_WAIT(); asm volatile("" ::: "memory");
    const int c = lane & 7;
#pragma unroll
    for (int j = 0; j < 4; ++j) { const int nl = (lane >> 3) + 8 * j; const LAS float* s = scr + (8 * c) * 33 + nl;
        v4u o; o.x = pk2(s[0 * 33], s[1 * 33]); o.y = pk2(s[2 * 33], s[3 * 33]); o.z = pk2(s[4 * 33], s[5 * 33]); o.w = pk2(s[6 * 33], s[7 * 33]);
        if (n0 + nl < N) *(GAS v4u*)(WT + (size_t)map(n0 + nl) * K + k0 + 8 * c) = o; }
    LDS_WAIT(); asm volatile("" ::: "memory");
}

struct Ptrs {
    const float *x, *p, *w_in, *b_in, *w_o_attn, *w_dw, *b_dw, *conv_ln_g, *conv_ln_b, *w_o_conv, *w_out, *ln1_g, *ln1_b, *w_router, *b_router, *w_gate_up, *b_gate_up, *w_down, *b_down,
        *w_ple_gate, *w_ple_proj, *ln2_g, *ln2_b, *rel_bias;
    float* out; unsigned char* ws;
};

__device__ __forceinline__ void ph_prologue(const Ptrs& P, LAS unsigned char* lds, int G) {
    const int tid = threadIdx.x, lane = tid & 63, wave = __builtin_amdgcn_readfirstlane(tid >> 6);
    unsigned char* ws = P.ws;
    LAS float* scr = (LAS float*)(lds + RING_OFF + wave * 16384);
    const int gw = blockIdx.x * NWAVES + wave, NGW = G * NWAVES;
    constexpr int I_IN = 16 * 163, I_OA = 8 * 32, I_OC = 8 * 32, I_OUT = 16 * 32, I_PG = 16 * 32, I_PP = 4 * 32, I_GU1 = 16 * 64, I_D1 = 16 * 32;
    constexpr int NITEMS = I_IN + I_OA + I_OC + I_OUT + I_PG + I_PP + NE * I_GU1 + NE * I_D1;
    for (int it = gw; it < NITEMS; it += NGW) {
        int r = it;
        if (r < I_IN) { transpose_item(P.w_in, D, IN_COLS, (bf16*)(ws + WS_WIN), scr, r, lane, map_in); continue; } r -= I_IN;
        if (r < I_OA) { transpose_item(P.w_o_attn, AW, D, (bf16*)(ws + WS_WOA), scr, r, lane, map_id); continue; } r -= I_OA;
        if (r < I_OC) { transpose_item(P.w_o_conv, CCH, D, (bf16*)(ws + WS_WOC), scr, r, lane, map_id); continue; } r -= I_OC;
        if (r < I_OUT) { transpose_item(P.w_out, D, D, (bf16*)(ws + WS_WOUT), scr, r, lane, map_id); continue; } r -= I_OUT;
        if (r < I_PG) { transpose_item(P.w_ple_gate, D, D, (bf16*)(ws + WS_WPG), scr, r, lane, map_id); continue; } r -= I_PG;
        if (r < I_PP) { transpose_item(P.w_ple_proj, PLE, D, (bf16*)(ws + WS_WPP), scr, r, lane, map_id); continue; } r -= I_PP;
        if (r < NE * I_GU1) { const int e = r / I_GU1; transpose_item(P.w_gate_up + (size_t)e * D * 2 * DE, D, 2 * DE, (bf16*)(ws + WS_WGU) + (size_t)e * 2 * DE * D, scr, r % I_GU1, lane, map_gu); continue; } r -= NE * I_GU1;
        { const int e = r / I_D1; transpose_item(P.w_down + (size_t)e * DE * D, DE, D, (bf16*)(ws + WS_WD) + (size_t)e * D * DE, scr, r % I_D1, lane, map_id); }
    }
    const size_t gt = (size_t)blockIdx.x * (NWAVES * 64) + tid, NT = (size_t)G * NWAVES * 64;
    for (size_t i = gt; i < (size_t)M * D / 8; i += NT) { const f32x4 a = ((const GAS f32x4*)P.x)[2 * i], b = ((const GAS f32x4*)P.x)[2 * i + 1];
        v4u o; o.x = pk2(a.x, a.y); o.y = pk2(a.z, a.w); o.z = pk2(b.x, b.y); o.w = pk2(b.z, b.w); ((GAS v4u*)(ws + WS_XB))[i] = o; }
    for (size_t i = gt; i < (size_t)M * PLE / 8; i += NT) { const f32x4 a = ((const GAS f32x4*)P.p)[2 * i], b = ((const GAS f32x4*)P.p)[2 * i + 1];
        v4u o; o.x = pk2(a.x, a.y); o.y = pk2(a.z, a.w); o.z = pk2(b.x, b.y); o.w = pk2(b.z, b.w); ((GAS v4u*)(ws + WS_PB))[i] = o; }
    float* biasp = (float*)(ws + WS_BIASP); float* bgup = (float*)(ws + WS_BGUP); float* rt = (float*)(ws + WS_RT);
    for (size_t i = gt; i < (size_t)IN_COLS; i += NT) biasp[map_in((int)i)] = P.b_in[i];
    for (size_t i = gt; i < (size_t)NE * 2 * DE; i += NT) { const int e = (int)(i >> 11), n = (int)(i & 2047); bgup[e * 2048 + map_gu(n)] = P.b_gate_up[i]; }
    for (size_t i = gt; i < (size_t)NH * 128; i += NT) { const int h = (int)(i >> 7), rel = (int)(i & 127);
        int bkt; if (rel < 16) bkt = rel; else { bkt = 16 + (int)(logf((float)rel * (1.0f / 16.0f)) / logf(8.0f) * 16.0f); bkt = bkt > 31 ? 31 : bkt; }
        rt[h * 128 + rel] = P.rel_bias[bkt * NH + h] * LOG2E; }
}

using pg8::Unit; using pg8::cvt_pk_bf16; using pg8::HALF; using pg8::BM;
__device__ __forceinline__ v4u pack8(const f32x4& a, const f32x4& b) { v4u w; w.x = cvt_pk_bf16(a[0], a[1]); w.y = cvt_pk_bf16(a[2], a[3]); w.z = cvt_pk_bf16(b[0], b[1]); w.w = cvt_pk_bf16(b[2], b[3]); return w; }
__device__ __forceinline__ f32x4 sig4(const f32x4& a) { f32x4 r; r[0] = sigmoidf_(a[0]); r[1] = sigmoidf_(a[1]); r[2] = sigmoidf_(a[2]); r[3] = sigmoidf_(a[3]); return r; }
__device__ __forceinline__ void unpack8(const v4u w, f32x4& a, f32x4& b) { a[0] = bflo(w.x); a[1] = bfhi(w.x); a[2] = bflo(w.y); a[3] = bfhi(w.y); b[0] = bflo(w.z); b[1] = bfhi(w.z); b[2] = bflo(w.w); b[3] = bfhi(w.w); }

struct EpiProj {
    static constexpr bool PERM = true;
    unsigned char* ws; const float* biasp;
    __device__ __forceinline__ void operator()(const f32x4 (&acc)[2][2][4][2], const Unit& u, int wr, int wc, int fr, int fq) const {
        const int row0 = u.pm * BM + wr * 64 + fr, cl0 = wc * 32 + 8 * fq, pn = u.pn;
        f32x4 bv[2][2];
#pragma unroll
        for (int bj = 0; bj < 2; ++bj)
#pragma unroll
            for (int n = 0; n < 2; ++n) bv[bj][n] = *(const f32x4*)(biasp + pn * BM + cl0 + bj * HALF + 4 * n);
#pragma unroll
        for (int ai = 0; ai < 2; ++ai)
#pragma unroll
            for (int m = 0; m < 4; ++m) { const size_t row = (size_t)(row0 + ai * HALF + m * 16);
#pragma unroll
                for (int bj = 0; bj < 2; ++bj) { f32x4 v0 = acc[ai][bj][m][0] + bv[bj][0], v1 = acc[ai][bj][m][1] + bv[bj][1]; const int cl = cl0 + bj * HALF;
                    if (pn < 8) { const int t = pn >> 1; if (t == 0) { v0 = v0 * C2; v1 = v1 * C2; }
                        bf16* base = (bf16*)(ws + WS_Q + (size_t)t * (WS_K - WS_Q)); *(v4u*)(base + row * 512 + (pn & 1) * 256 + cl) = pack8(v0, v1); }
                    else if (pn < 12) { const f32x4 s = sig4(v1); v2u w; w.x = cvt_pk_bf16(v0[0] * s[0], v0[1] * s[1]); w.y = cvt_pk_bf16(v0[2] * s[2], v0[3] * s[3]);
                        *(v2u*)((bf16*)(ws + WS_U) + row * 512 + (pn - 8) * 128 + (cl >> 1)) = w; }
                    else if (pn < 20) { *(v4u*)((bf16*)(ws + WS_SG) + row * 2048 + (pn - 12) * 256 + cl) = pack8(sig4(v0), sig4(v1)); }
                    else { if (cl < 64) *(v4u*)((bf16*)(ws + WS_KI) + row * 64 + cl) = pack8(v0, v1);
                           else if (cl == 64) { float* wi = (float*)(ws + WS_WI) + row * 8; *(f32x4*)wi = v0; *(f32x4*)(wi + 4) = v1; } }
                } }
    }
};
template <bool ADD> struct EpiGated {
    static constexpr bool PERM = true;
    const bf16* G; int goff; const bf16* T; bf16* O;
    __device__ __forceinline__ void operator()(const f32x4 (&acc)[2][2][4][2], const Unit& u, int wr, int wc, int fr, int fq) const {
        const int row0 = u.pm * BM + wr * 64 + fr, col0 = u.pn * BM + wc * 32 + 8 * fq;
#pragma unroll
        for (int ai = 0; ai < 2; ++ai)
#pragma unroll
            for (int m = 0; m < 4; ++m) { const size_t row = (size_t)(row0 + ai * HALF + m * 16);
#pragma unroll
                for (int bj = 0; bj < 2; ++bj) { const int col = col0 + bj * HALF; f32x4 g0, g1; unpack8(*(const v4u*)(G + row * 2048 + goff + col), g0, g1);
                    f32x4 v0 = acc[ai][bj][m][0] * g0, v1 = acc[ai][bj][m][1] * g1;
                    if (ADD) { f32x4 t0, t1; unpack8(*(const v4u*)(T + row * 1024 + col), t0, t1); v0 = v0 + t0; v1 = v1 + t1; }
                    *(v4u*)(O + row * 1024 + col) = pack8(v0, v1); } }
    }
};
struct EpiRes {
    static constexpr bool PERM = false;
    const float* X; float* O;
    __device__ __forceinline__ void operator()(const f32x4 (&acc)[2][2][4][2], const Unit& u, int wr, int wc, int fr, int fq) const {
        const int row0 = u.pm * BM + wr * 64 + fr, col0 = u.pn * BM + wc * 32 + 4 * fq;
#pragma unroll
        for (int ai = 0; ai < 2; ++ai)
#pragma unroll
            for (int m = 0; m < 4; ++m) { const size_t off = (size_t)(row0 + ai * HALF + m * 16) * D + col0;
#pragma unroll
                for (int bj = 0; bj < 2; ++bj)
#pragma unroll
                    for (int n = 0; n < 2; ++n) { const f32x4 xv = *(const f32x4*)(X + off + bj * HALF + n * 16); *(f32x4*)(O + off + bj * HALF + n * 16) = xv * ALPHA + acc[ai][bj][m][n]; }
                asm volatile("" ::: "memory"); }
    }
};
struct EpiSwiglu {
    static constexpr bool PERM = true;
    const float* bgup; bf16* HB;
    __device__ __forceinline__ void operator()(const f32x4 (&acc)[2][2][4][2], const Unit& u, int wr, int wc, int fr, int fq) const {
        const int row0 = u.pm * BM + wr * 64 + fr, cl0 = u.pn * BM + wc * 32 + 8 * fq;
        f32x4 bv[2][2];
#pragma unroll
        for (int bj = 0; bj < 2; ++bj)
#pragma unroll
            for (int n = 0; n < 2; ++n) bv[bj][n] = *(const f32x4*)(bgup + u.e * 2048 + cl0 + bj * HALF + 4 * n);
#pragma unroll
        for (int ai = 0; ai < 2; ++ai)
#pragma unroll
            for (int m = 0; m < 4; ++m) { const size_t row = (size_t)(row0 + ai * HALF + m * 16);
#pragma unroll
                for (int bj = 0; bj < 2; ++bj) { const f32x4 g = acc[ai][bj][m][0] + bv[bj][0], uu = acc[ai][bj][m][1] + bv[bj][1]; float a[4];
#pragma unroll
                    for (int j = 0; j < 4; ++j) { const float gg = fminf(g[j], 7.0f), uc = fminf(fmaxf(uu[j], -7.0f), 7.0f); a[j] = (uc + 1.0f) * gg * sigmoidf_(1.702f * gg); }
                    v2u w; w.x = cvt_pk_bf16(a[0], a[1]); w.y = cvt_pk_bf16(a[2], a[3]);
                    *(v2u*)(HB + row * 1024 + ((cl0 + bj * HALF) >> 1)) = w; } }
    }
};
struct EpiDown {
    static constexpr bool PERM = true;
    const float* bd; const float* rowgate; bf16* Y;
    __device__ __forceinline__ void operator()(const f32x4 (&acc)[2][2][4][2], const Unit& u, int wr, int wc, int fr, int fq) const {
        const int row0 = u.pm * BM + wr * 64 + fr, col0 = u.pn * BM + wc * 32 + 8 * fq;
        f32x4 bv[2][2];
#pragma unroll
        for (int bj = 0; bj < 2; ++bj)
#pragma unroll
            for (int n = 0; n < 2; ++n) bv[bj][n] = *(const f32x4*)(bd + u.e * 1024 + col0 + bj * HALF + 4 * n);
#pragma unroll
        for (int ai = 0; ai < 2; ++ai)
#pragma unroll
            for (int m = 0; m < 4; ++m) { const size_t row = (size_t)(row0 + ai * HALF + m * 16); const float gt = rowgate[row];
#pragma unroll
                for (int bj = 0; bj < 2; ++bj) *(v4u*)(Y + row * 1024 + col0 + bj * HALF) = pack8((acc[ai][bj][m][0] + bv[bj][0]) * gt, (acc[ai][bj][m][1] + bv[bj][1]) * gt); }
    }
};
struct EpiPlain {
    static constexpr bool PERM = true;
    bf16* O;
    __device__ __forceinline__ void operator()(const f32x4 (&acc)[2][2][4][2], const Unit& u, int wr, int wc, int fr, int fq) const {
        const int row0 = u.pm * BM + wr * 64 + fr, col0 = u.pn * BM + wc * 32 + 8 * fq;
#pragma unroll
        for (int ai = 0; ai < 2; ++ai)
#pragma unroll
            for (int m = 0; m < 4; ++m) { const size_t row = (size_t)(row0 + ai * HALF + m * 16);
#pragma unroll
                for (int bj = 0; bj < 2; ++bj) *(v4u*)(O + row * 1024 + col0 + bj * HALF) = pack8(acc[ai][bj][m][0], acc[ai][bj][m][1]); }
    }
};
struct EpiPle {
    static constexpr bool PERM = false;
    const float* HH; const bf16* PP; float* O;
    __device__ __forceinline__ void operator()(const f32x4 (&acc)[2][2][4][2], const Unit& u, int wr, int wc, int fr, int fq) const {
        const int row0 = u.pm * BM + wr * 64 + fr, col0 = u.pn * BM + wc * 32 + 4 * fq;
#pragma unroll
        for (int ai = 0; ai < 2; ++ai)
#pragma unroll
            for (int m = 0; m < 4; ++m) { const size_t off = (size_t)(row0 + ai * HALF + m * 16) * D + col0;
#pragma unroll
                for (int bj = 0; bj < 2; ++bj)
#pragma unroll
                    for (int n = 0; n < 2; ++n) { const size_t o = off + bj * HALF + n * 16; const f32x4 hv = *(const f32x4*)(HH + o); const v2u pw = *(const v2u*)(PP + o);
                        f32x4 pp; pp[0] = bflo(pw.x); pp[1] = bfhi(pw.x); pp[2] = bflo(pw.y); pp[3] = bfhi(pw.y);
                        *(f32x4*)(O + o) = hv + sig4(acc[ai][bj][m][n]) * pp; }
                asm volatile("" ::: "memory"); }
    }
};

template <bool GATH> struct MoeOrder {
    static constexpr bool GATHER = GATH;
    const LAS int* off; int NT, G, c; const int* rowtok; int K; size_t bstride;
    __device__ __forceinline__ bool next(int i, Unit& u) const {
        int L = i * G + c, cum = 0;
        for (int e = 0; e < NE; ++e) { const int tiles = (off[e + 1] - off[e]) >> 8, nu = tiles * NT;
            if (L < cum + nu) { const int loc = L - cum; u.e = e; u.pm = (off[e] >> 8) + loc % tiles; u.pn = loc / tiles; return true; }
            cum += nu; }
        return false;
    }
    __device__ __forceinline__ const char* a_base(const pg8::Gemm& g, const Unit& u) const { return GATH ? (const char*)g.A : (const char*)g.A + (size_t)u.pm * ((size_t)BM * g.K * 2); }
    __device__ __forceinline__ const char* b_base(const pg8::Gemm& g, const Unit& u) const { return (const char*)g.Bt + (size_t)u.e * bstride + (size_t)u.pn * ((size_t)BM * g.K * 2); }
    __device__ __forceinline__ unsigned a_rowoff(const Unit& u, int h, int R) const { return (unsigned)rowtok[u.pm * BM + h * HALF + R] * (unsigned)(K * 2); }
};

__device__ __forceinline__ void ph_conv(const Ptrs& P, LAS unsigned char* lds, int G) {
    const int tid = threadIdx.x, lane = tid & 63, wave = __builtin_amdgcn_readfirstlane(tid >> 6);
    const bf16* U = (const bf16*)(P.ws + WS_U); bf16* CO = (bf16*)(P.ws + WS_CO);
    LAS bf16* ul = (LAS bf16*)(lds);
    LAS float* yl = (LAS float*)(lds + 65536);
    float w[CWID];
#pragma unroll
    for (int j = 0; j < CWID; ++j) w[j] = P.w_dw[j * CCH + tid];
    const float bdw = P.b_dw[tid];
    f32x4 lg[2], lb[2];
    lg[0] = *(const f32x4*)(P.conv_ln_g + 8 * lane); lg[1] = *(const f32x4*)(P.conv_ln_g + 8 * lane + 4);
    lb[0] = *(const f32x4*)(P.conv_ln_b + 8 * lane); lb[1] = *(const f32x4*)(P.conv_ln_b + 8 * lane + 4);
    for (int ch = blockIdx.x; ch < M / 32; ch += G) {
        const int t0 = ch * 32;
        for (int i = tid; i < 62 * 64; i += 512) { const int r = i >> 6, c8 = i & 63; const int t = t0 - 30 + r;
            v4u v = (v4u){0u, 0u, 0u, 0u}; if (t >= 0) v = *(const GAS v4u*)(U + (size_t)t * CCH + c8 * 8);
            *(LAS v4u*)(ul + r * CCH + c8 * 8) = v; }
        __syncthreads();
        float uu[62];
#pragma unroll
        for (int r = 0; r < 62; ++r) uu[r] = bf2f(ul[r * CCH + tid]);
        float acc[32];
#pragma unroll
        for (int i = 0; i < 32; ++i) { float a = bdw;
#pragma unroll
            for (int j = 0; j < CWID; ++j) a += w[j] * uu[i + j];
            acc[i] = a; }
#pragma unroll
        for (int i = 0; i < 32; ++i) yl[i * CCH + tid] = acc[i];
        __syncthreads();
#pragma unroll
        for (int q = 0; q < 4; ++q) { const int tt = wave + 8 * q;
            f32x4 a = *(const LAS f32x4*)(yl + tt * CCH + 8 * lane), b = *(const LAS f32x4*)(yl + tt * CCH + 8 * lane + 4);
            const float mean = wave_sum((a[0] + a[1]) + (a[2] + a[3]) + (b[0] + b[1]) + (b[2] + b[3])) * (1.0f / CCH);
            a = a - mean; b = b - mean;
            const float var = wave_sum((a[0] * a[0] + a[1] * a[1]) + (a[2] * a[2] + a[3] * a[3]) + (b[0] * b[0] + b[1] * b[1]) + (b[2] * b[2] + b[3] * b[3])) * (1.0f / CCH);
            const float rstd = 1.0f / sqrtf(var + LN_EPS);
            a = a * rstd * lg[0] + lb[0]; b = b * rstd * lg[1] + lb[1];
            a = a * sig4(a); b = b * sig4(b);
            *(GAS v4u*)(CO + (size_t)(t0 + tt) * CCH + 8 * lane) = pack8(a, b); }
        __syncthreads();
    }
}

__device__ __forceinline__ void ph_index_slow(const Ptrs& P, LAS unsigned char* lds, int G) {
    const int tid = threadIdx.x, lane = tid & 63, wave = __builtin_amdgcn_readfirstlane(tid >> 6);
    const bf16* QI = (const bf16*)(P.ws + WS_QI); const bf16* KI = (const bf16*)(P.ws + WS_KI); const float* WI = (const float*)(P.ws + WS_WI);
    unsigned* MASK = (unsigned*)(P.ws + WS_MASK);
    LAS float* sc = (LAS float*)lds;
    LAS float* qs = (LAS float*)lds_opaque(lds + 65536);
    LAS unsigned* hist = (LAS unsigned*)(lds + 65536 + 2048);
    LAS unsigned* ctl = hist + 256;
    LAS float* wsm = (LAS float*)(ctl + 8);
    for (int t = blockIdx.x; t < M; t += G) {
        qs[tid] = bf2f(QI[(size_t)t * 512 + tid]); if (tid < 8) wsm[tid] = WI[(size_t)t * 8 + tid];
        __syncthreads();
        const int n = t + 1;
        for (int s = tid; s < n; s += 512) {
            asm volatile("" ::: "memory");
            float d[8];
#pragma unroll
            for (int h = 0; h < 8; ++h) d[h] = 0.f;
#pragma unroll
            for (int c = 0; c < 8; ++c) { const v4u v = *(const GAS v4u*)(KI + (size_t)s * 64 + c * 8);
                const float k0 = bflo(v.x), k1 = bfhi(v.x), k2 = bflo(v.y), k3 = bfhi(v.y), k4 = bflo(v.z), k5 = bfhi(v.z), k6 = bflo(v.w), k7 = bfhi(v.w);
#pragma unroll
                for (int h = 0; h < 8; ++h) { const f32x4 qa = *(const LAS f32x4*)(qs + h * 64 + c * 8), qb = *(const LAS f32x4*)(qs + h * 64 + c * 8 + 4);
                    d[h] += (qa[0] * k0 + qa[1] * k1) + (qa[2] * k2 + qa[3] * k3) + (qb[0] * k4 + qb[1] * k5) + (qb[2] * k6 + qb[3] * k7); }
                __builtin_amdgcn_sched_barrier(0); }
            float score = 0.f;
#pragma unroll
            for (int h = 0; h < 8; ++h) score += wsm[h] * fmaxf(d[h], 0.f);
            sc[s] = score;
        }
        __syncthreads();
        unsigned tkey = 0u;
        if (n > TOPK) {
            unsigned prefix = 0u; int krem = TOPK;
            for (int shift = 24; shift >= 0; shift -= 8) {
                if (tid < 256) hist[tid] = 0u;
                __syncthreads();
                for (int s = tid; s < n; s += 512) { const unsigned key = f2key(sc[s]); const bool match = (shift == 24) ? true : ((key >> (shift + 8)) == (prefix >> (shift + 8)));
                    if (match) atomicAdd((unsigned*)&hist[(key >> shift) & 255u], 1u); }
                __syncthreads();
                if (wave == 0) {
                    unsigned c0 = hist[4 * lane], c1 = hist[4 * lane + 1], c2 = hist[4 * lane + 2], c3 = hist[4 * lane + 3];
                    const unsigned tot = c0 + c1 + c2 + c3; unsigned suf = tot;
#pragma unroll
                    for (int o = 1; o < 64; o <<= 1) { const unsigned v = __shfl_down(suf, o); if (lane + o < 64) suf += v; }
                    const unsigned above = suf - tot;
                    if (suf >= (unsigned)krem && above < (unsigned)krem) {
                        unsigned cum = above; int digit; unsigned newk;
                        if (cum + c3 >= (unsigned)krem) { digit = 4 * lane + 3; newk = krem - cum; }
                        else { cum += c3; if (cum + c2 >= (unsigned)krem) { digit = 4 * lane + 2; newk = krem - cum; }
                            else { cum += c2; if (cum + c1 >= (unsigned)krem) { digit = 4 * lane + 1; newk = krem - cum; } else { cum += c1; digit = 4 * lane; newk = krem - cum; } } }
                        ctl[0] = prefix | ((unsigned)digit << shift); ctl[1] = newk;
                    }
                }
                __syncthreads();
                prefix = ctl[0]; krem = (int)ctl[1];
            }
            tkey = prefix;
        }
        for (int c = wave; c < 256; c += 8) { const int s = 64 * c + lane; const bool bit = (s < n) && (f2key(sc[s < n ? s : 0]) >= tkey);
            const unsigned long long m = __ballot(bit);
            if (lane == 0) { MASK[(size_t)t * 512 + 2 * c] = (unsigned)m; MASK[(size_t)t * 512 + 2 * c + 1] = (unsigned)(m >> 32); } }
        __syncthreads();
    }
}


constexpr int IX_CAP = 640, IX_LIM = IX_CAP - 32;
__device__ __forceinline__ float key2f(unsigned k) { const unsigned u = (k & 0x80000000u) ? (k & 0x7fffffffu) : ~k; return __builtin_bit_cast(float, u); }
__device__ __forceinline__ int lanes_below(unsigned long long m) { return (int)__builtin_amdgcn_mbcnt_hi((unsigned)(m >> 32), __builtin_amdgcn_mbcnt_lo((unsigned)m, 0u)); }
__device__ __forceinline__ float ix_compact(LAS float* v, LAS unsigned short* ix, LAS unsigned* hist, int n, int lane) {
    unsigned key[10]; unsigned id[10]; unsigned vm = 0u;
#pragma unroll
    for (int j = 0; j < 10; ++j) { const int i = j * 64 + lane; const bool ok = i < n; key[j] = ok ? f2key(v[ok ? i : 0]) : 0u; id[j] = ok ? (unsigned)ix[ok ? i : 0] : 0u; vm |= ok ? (1u << j) : 0u; }
    unsigned prefix = 0u; int krem = TOPK;
#pragma unroll
    for (int shift = 24; shift >= 0; shift -= 8) {
        *(LAS v4u*)(hist + 4 * lane) = (v4u){0u, 0u, 0u, 0u};
        LDS_WAIT();
#pragma unroll
        for (int j = 0; j < 10; ++j) { const bool match = ((vm >> j) & 1u) && (shift == 24 ? true : ((key[j] >> ((shift + 8) & 31)) == (prefix >> ((shift + 8) & 31))));
            if (match) __hip_atomic_fetch_add(hist + ((key[j] >> shift) & 255u), 1u, __ATOMIC_RELAXED, __HIP_MEMORY_SCOPE_WAVEFRONT); }
        LDS_WAIT();
        const v4u c = *(const LAS v4u*)(hist + 4 * lane);
        const unsigned tot = (c.x + c.y) + (c.z + c.w); unsigned suf = tot;
#pragma unroll
        for (int o = 1; o < 64; o <<= 1) { const unsigned t = __shfl_down(suf, o); if (lane + o < 64) suf += t; }
        const unsigned above = suf - tot, kr = (unsigned)krem;
        const bool mine = (suf >= kr) && (above < kr);
        unsigned cum = above; int digit; unsigned newk;
        if (cum + c.w >= kr) { digit = 4 * lane + 3; newk = kr - cum; }
        else { cum += c.w; if (cum + c.z >= kr) { digit = 4 * lane + 2; newk = kr - cum; }
            else { cum += c.z; if (cum + c.y >= kr) { digit = 4 * lane + 1; newk = kr - cum; } else { cum += c.y; digit = 4 * lane; newk = kr - cum; } } }
        const unsigned long long mm = __ballot(mine);
        const int src = mm ? (int)__builtin_ctzll(mm) : 0;
        digit = __shfl(digit, src); newk = __shfl(newk, src);
        prefix |= ((unsigned)digit << shift); krem = (int)newk;
        LDS_WAIT();
    }
    const unsigned tkey = prefix;
    int kept = 0, ties = 0;
#pragma unroll
    for (int j = 0; j < 10; ++j) { const bool ok = (vm >> j) & 1u; const bool gt = ok && key[j] > tkey, eq = ok && key[j] == tkey;
        const unsigned long long meq = __ballot(eq); const bool keepeq = eq && (ties + lanes_below(meq) < krem); ties += __builtin_popcountll(meq);
        const bool keep = gt || keepeq; const unsigned long long mk = __ballot(keep); const int pos = kept + lanes_below(mk);
        if (keep) { v[pos] = key2f(key[j]); ix[pos] = (unsigned short)id[j]; }
        kept += __builtin_popcountll(mk); }
    LDS_WAIT();
    return key2f(tkey);
}
__device__ __forceinline__ void ph_index_fast(const Ptrs& P, LAS unsigned char* lds, int G) {
    const int tid = threadIdx.x, lane = tid & 63, wave = __builtin_amdgcn_readfirstlane(tid >> 6), l32 = lane & 31, hi = lane >> 5;
    const bf16* QI = (const bf16*)(P.ws + WS_QI); const bf16* KI = (const bf16*)(P.ws + WS_KI); const float* WI = (const float*)(P.ws + WS_WI);
    unsigned* MASK = (unsigned*)(P.ws + WS_MASK);
    LAS unsigned char* wl = lds + wave * 16384;
    LAS float* vals = (LAS float*)wl;
    LAS unsigned short* idxs = (LAS unsigned short*)(wl + 10240);
    LAS unsigned* hist = (LAS unsigned*)(wl + 15360);
    LAS unsigned* bm = (LAS unsigned*)wl;
    const int rho = l32, jA = 2 * ((rho >> 2) & 1) + (rho >> 4), headA = 4 * ((rho >> 3) & 1) + (rho & 3);
    for (int b2 = blockIdx.x; b2 < 256; b2 += G)
        for (int half = 0; half < 2; ++half) {
            const int qblk = half ? 511 - b2 : b2, t0 = qblk * 32 + wave * 4;
            bf16x8 A[4];
#pragma unroll
            for (int ks = 0; ks < 4; ++ks) A[ks] = *(const GAS bf16x8*)(QI + (size_t)(t0 + jA) * 512 + headA * 64 + ks * 16 + hi * 8);
            float w[2][8];
#pragma unroll
            for (int jj = 0; jj < 2; ++jj) { const f32x4 a = *(const GAS f32x4*)(WI + (size_t)(t0 + 2 * hi + jj) * 8), b = *(const GAS f32x4*)(WI + (size_t)(t0 + 2 * hi + jj) * 8 + 4);
                w[jj][0] = a[0]; w[jj][1] = a[1]; w[jj][2] = a[2]; w[jj][3] = a[3]; w[jj][4] = b[0]; w[jj][5] = b[1]; w[jj][6] = b[2]; w[jj][7] = b[3]; }
            int cnt[4] = {0, 0, 0, 0}; float tau[4] = {-INFINITY, -INFINITY, -INFINITY, -INFINITY};
            const int nkt = (t0 >> 5) + 1, qt0 = t0 + 2 * hi;
            bf16x8 B[4], Bn[4];
#pragma unroll
            for (int ks = 0; ks < 4; ++ks) B[ks] = *(const GAS bf16x8*)(KI + (size_t)l32 * 64 + ks * 16 + hi * 8);
            for (int kt = 0; kt <= nkt; ++kt) {
                if (kt < nkt) {
                    const int ktn = (kt + 1 < nkt) ? kt + 1 : kt;
#pragma unroll
                    for (int ks = 0; ks < 4; ++ks) Bn[ks] = *(const GAS bf16x8*)(KI + (size_t)(ktn * 32 + l32) * 64 + ks * 16 + hi * 8);
                    f32x16 acc;
#pragma unroll
                    for (int i = 0; i < 16; ++i) acc[i] = 0.f;
#pragma unroll
                    for (int ks = 0; ks < 4; ++ks) acc = __builtin_amdgcn_mfma_f32_32x32x16_bf16(A[ks], B[ks], acc, 0, 0, 0);
                    float s0 = 0.f, s1 = 0.f;
#pragma unroll
                    for (int h = 0; h < 8; ++h) { s0 += w[0][h] * fmaxf(acc[h], 0.f); s1 += w[1][h] * fmaxf(acc[8 + h], 0.f); }
                    const int key = kt * 32 + l32;
                    const float ta0 = hi ? tau[2] : tau[0], ta1 = hi ? tau[3] : tau[1];
                    const bool p0 = (s0 > ta0) && (key <= qt0), p1 = (s1 > ta1) && (key <= qt0 + 1);
                    const unsigned long long m0 = __ballot(p0), m1 = __ballot(p1);
                    if (m0) { const unsigned lo = (unsigned)m0, hh = (unsigned)(m0 >> 32); const int pos = hi ? cnt[2] + (int)__builtin_amdgcn_mbcnt_hi(hh, 0u) : cnt[0] + (int)__builtin_amdgcn_mbcnt_lo(lo, 0u);
                        if (p0) { const int q = 2 * hi; vals[q * IX_CAP + pos] = s0; idxs[q * IX_CAP + pos] = (unsigned short)key; }
                        cnt[0] += __builtin_popcount(lo); cnt[2] += __builtin_popcount(hh); }
                    if (m1) { const unsigned lo = (unsigned)m1, hh = (unsigned)(m1 >> 32); const int pos = hi ? cnt[3] + (int)__builtin_amdgcn_mbcnt_hi(hh, 0u) : cnt[1] + (int)__builtin_amdgcn_mbcnt_lo(lo, 0u);
                        if (p1) { const int q = 2 * hi + 1; vals[q * IX_CAP + pos] = s1; idxs[q * IX_CAP + pos] = (unsigned short)key; }
                        cnt[1] += __builtin_popcount(lo); cnt[3] += __builtin_popcount(hh); }
#pragma unroll
                    for (int ks = 0; ks < 4; ++ks) B[ks] = Bn[ks];
                }
                const int lim = (kt == nkt) ? TOPK : IX_LIM;
                if (cnt[0] > lim || cnt[1] > lim || cnt[2] > lim || cnt[3] > lim) {
                    LDS_WAIT();
#pragma unroll
                    for (int q = 0; q < 4; ++q) if (cnt[q] > lim) { tau[q] = ix_compact(vals + q * IX_CAP, idxs + q * IX_CAP, hist, cnt[q], lane); cnt[q] = TOPK; }
                }
            }
            LDS_WAIT();
#pragma unroll
            for (int r = 0; r < 8; ++r) *(LAS v4u*)(bm + r * 256 + lane * 4) = (v4u){0u, 0u, 0u, 0u};
            LDS_WAIT();
#pragma unroll
            for (int q = 0; q < 4; ++q)
#pragma unroll
                for (int j = 0; j < 4; ++j) { const int i = j * 64 + lane; if (i < cnt[q]) { const unsigned k = idxs[q * IX_CAP + i]; __hip_atomic_fetch_or(bm + q * 512 + (k >> 5), 1u << (k & 31u), __ATOMIC_RELAXED, __HIP_MEMORY_SCOPE_WAVEFRONT); } }
            LDS_WAIT();
#pragma unroll
            for (int q = 0; q < 4; ++q)
#pragma unroll
                for (int r = 0; r < 2; ++r) *(GAS v4u*)(MASK + (size_t)(t0 + q) * 512 + r * 256 + lane * 4) = *(const LAS v4u*)(bm + q * 512 + r * 256 + lane * 4);
            LDS_WAIT();
        }
}

__device__ __forceinline__ void ph_attn_slow(const Ptrs& P, int G) {
    const int tid = threadIdx.x, lane = tid & 63, wave = __builtin_amdgcn_readfirstlane(tid >> 6);
    const bf16* Q = (const bf16*)(P.ws + WS_Q); const bf16* K = (const bf16*)(P.ws + WS_K); const bf16* V = (const bf16*)(P.ws + WS_V);
    const unsigned* MASK = (const unsigned*)(P.ws + WS_MASK); const float* RT = (const float*)(P.ws + WS_RT); bf16* AO = (bf16*)(P.ws + WS_AO);
    const int head = lane >> 3, sub = lane & 7, co = head * 64 + sub * 8;
    const int gw = blockIdx.x * NWAVES + wave, NGW = G * NWAVES;
    for (int t = gw; t < M; t += NGW) {
        f32x4 q0, q1; unpack8(*(const GAS v4u*)(Q + (size_t)t * 512 + co), q0, q1);
        float m = -INFINITY, l = 0.f; f32x4 a0 = (f32x4){0.f, 0.f, 0.f, 0.f}, a1 = a0;
        const unsigned* mrow = MASK + (size_t)t * 512; const int nw = (t >> 5) + 1;
        for (int w = 0; w < nw; ++w) {
            unsigned word = __builtin_amdgcn_readfirstlane(mrow[w]);
            while (word) { const int b = __builtin_ctz(word); word &= word - 1u; const int s = 32 * w + b;
                f32x4 k0, k1; unpack8(*(const GAS v4u*)(K + (size_t)s * 512 + co), k0, k1);
                f32x4 v0, v1; unpack8(*(const GAS v4u*)(V + (size_t)s * 512 + co), v0, v1);
                float d = (q0[0] * k0[0] + q0[1] * k0[1]) + (q0[2] * k0[2] + q0[3] * k0[3]) + (q1[0] * k1[0] + q1[1] * k1[1]) + (q1[2] * k1[2] + q1[3] * k1[3]);
                d += __shfl_xor(d, 1); d += __shfl_xor(d, 2); d += __shfl_xor(d, 4);
                int rel = t - s; rel = rel > 127 ? 127 : rel;
                const float x = d + RT[head * 128 + rel];
                const float mn = fmaxf(m, x), scl = __builtin_amdgcn_exp2f(m - mn), p = __builtin_amdgcn_exp2f(x - mn);
                l = l * scl + p; a0 = a0 * scl + v0 * p; a1 = a1 * scl + v1 * p; m = mn; }
        }
        const float inv = 1.0f / l;
        *(GAS v4u*)(AO + (size_t)t * 512 + co) = pack8(a0 * inv, a1 * inv);
    }
}


typedef short v4i16_t __attribute__((ext_vector_type(4)));
__device__ __forceinline__ int crow(int r, int hi) { return (r & 3) + 8 * (r >> 2) + 4 * hi; }
__device__ __forceinline__ v4i16_t vtr(LAS const unsigned char* p) { return __builtin_amdgcn_ds_read_tr16_b64_v4i16((LAS v4i16_t*)p); }
__device__ __forceinline__ void ph_attn_fast(const Ptrs& P, LAS unsigned char* lds, int G) {
    const int tid = threadIdx.x, lane = tid & 63, wave = __builtin_amdgcn_readfirstlane(tid >> 6), r32 = lane & 31, hi = lane >> 5;
    const bf16* Q = (const bf16*)(P.ws + WS_Q); const bf16* K = (const bf16*)(P.ws + WS_K); const bf16* V = (const bf16*)(P.ws + WS_V);
    const unsigned* MASK = (const unsigned*)(P.ws + WS_MASK); const float* RT = (const float*)(P.ws + WS_RT); bf16* AO = (bf16*)(P.ws + WS_AO);
    LAS unsigned char* kv = lds;
    LAS float* scr = (LAS float*)(lds + 32768) + wave * 64;
    LAS float* rtl = (LAS float*)(lds + 32768 + 2048);
    const int skey = tid >> 3, scc = tid & 7;
    const int kdst = scc * 1024 + skey * 16, vdst = 8192 + (scc >> 2) * 4096 + skey * 64 + (scc & 3) * 16;
    const int vrd = 8192 + ((lane >> 4) & 1) * 32 + (lane & 3) * 8 + (4 * hi + ((lane & 15) >> 2)) * 64;
    for (int c = blockIdx.x; c < 256; c += G)
        for (int half = 0; half < 2; ++half) {
            const int h = c & 7, pp = c >> 3, qb = half ? 63 - pp : pp;
            const int q0 = qb * 256, qw = q0 + wave * 32, q = qw + r32, NT = (qb + 1) * 4;
            __syncthreads();
            if (tid < 128) rtl[tid] = RT[h * 128 + tid] - RT[h * 128 + 127];
            bf16x8 qr[4];
#pragma unroll
            for (int d0 = 0; d0 < 4; ++d0) qr[d0] = *(const GAS bf16x8*)(Q + (size_t)q * 512 + h * 64 + d0 * 16 + hi * 8);
            const bf16* kg = K + (size_t)skey * 512 + h * 64 + scc * 8; const bf16* vg = V + (size_t)skey * 512 + h * 64 + scc * 8;
            const unsigned* mg = MASK + (size_t)q * 512;
            v4u kr = *(const GAS v4u*)kg, vr = *(const GAS v4u*)vg; v2u mk = *(const GAS v2u*)mg;
            *(LAS v4u*)(kv + kdst) = kr; *(LAS v4u*)(kv + vdst) = vr;
            __syncthreads();
            float m = -INFINITY, l = 0.f; f32x16 o0, o1;
#pragma unroll
            for (int i = 0; i < 16; ++i) { o0[i] = 0.f; o1[i] = 0.f; }
            for (int t = 0; t < NT; ++t) {
                LAS unsigned char* kb = kv + (t & 1) * 16384;
                v2u mkn = mk;
                if (t + 1 < NT) { kr = *(const GAS v4u*)(kg + (size_t)(t + 1) * 64 * 512); vr = *(const GAS v4u*)(vg + (size_t)(t + 1) * 64 * 512); mkn = *(const GAS v2u*)(mg + 2 * (t + 1)); }
                f32x16 p0, p1;
#pragma unroll
                for (int i = 0; i < 16; ++i) { p0[i] = 0.f; p1[i] = 0.f; }
#pragma unroll
                for (int d0 = 0; d0 < 4; ++d0) { const bf16x8 k0 = *(const LAS bf16x8*)(kb + (2 * d0 + hi) * 1024 + r32 * 16), k1 = *(const LAS bf16x8*)(kb + (2 * d0 + hi) * 1024 + 512 + r32 * 16);
                    p0 = __builtin_amdgcn_mfma_f32_32x32x16_bf16(k0, qr[d0], p0, 0, 0, 0); p1 = __builtin_amdgcn_mfma_f32_32x32x16_bf16(k1, qr[d0], p1, 0, 0, 0); }
                if (64 * t + 63 >= qw - 127) {
#pragma unroll
                    for (int r = 0; r < 16; ++r) { const int rel = q - (64 * t + crow(r, hi));
                        if (rel >= 0 && rel < 128) p0[r] += rtl[rel];
                        if (rel >= 32 && rel < 160) p1[r] += rtl[rel - 32]; }
                }
                float rm = fmaxf(p0[0], p1[0]);
#pragma unroll
                for (int r = 1; r < 16; ++r) rm = fmaxf(rm, fmaxf(p0[r], p1[r]));
                rm = fmaxf(rm, __shfl_xor(rm, 32));
                const bool need = rm > m + 8.0f;
                if (__ballot(need)) {
                    const float mn = need ? rm : m, sc = __builtin_amdgcn_exp2f(m - mn);
                    l *= sc; m = mn;
                    if (hi == 0) scr[r32] = sc;
                    LDS_WAIT();
#pragma unroll
                    for (int a = 0; a < 4; ++a) { const f32x4 s4 = *(const LAS f32x4*)(scr + 8 * a + 4 * hi);
#pragma unroll
                        for (int j = 0; j < 4; ++j) { o0[4 * a + j] *= s4[j]; o1[4 * a + j] *= s4[j]; } }
                }
                const unsigned ml = mk.x >> (4 * hi), mh = mk.y >> (4 * hi);
                float ls = 0.f;
#pragma unroll
                for (int r = 0; r < 16; ++r) { const int cbit = (r & 3) + 8 * (r >> 2);
                    float e0 = __builtin_amdgcn_exp2f(p0[r] - m), e1 = __builtin_amdgcn_exp2f(p1[r] - m);
                    e0 = ((ml >> cbit) & 1u) ? e0 : 0.f; e1 = ((mh >> cbit) & 1u) ? e1 : 0.f;
                    p0[r] = e0; p1[r] = e1; ls += e0 + e1; }
                l += ls;
                bf16x8 pa[4];
#pragma unroll
                for (int ks = 0; ks < 4; ++ks) { v4u w;
                    if (ks < 2) { w.x = cvt_pk_bf16(p0[8 * ks], p0[8 * ks + 1]); w.y = cvt_pk_bf16(p0[8 * ks + 2], p0[8 * ks + 3]); w.z = cvt_pk_bf16(p0[8 * ks + 4], p0[8 * ks + 5]); w.w = cvt_pk_bf16(p0[8 * ks + 6], p0[8 * ks + 7]); }
                    else { const int k2 = ks - 2; w.x = cvt_pk_bf16(p1[8 * k2], p1[8 * k2 + 1]); w.y = cvt_pk_bf16(p1[8 * k2 + 2], p1[8 * k2 + 3]); w.z = cvt_pk_bf16(p1[8 * k2 + 4], p1[8 * k2 + 5]); w.w = cvt_pk_bf16(p1[8 * k2 + 6], p1[8 * k2 + 7]); }
                    pa[ks] = __builtin_bit_cast(bf16x8, w); }
#pragma unroll
                for (int ks = 0; ks < 4; ++ks) {
                    const v4i16_t a0 = vtr(kb + vrd + ks * 1024), a1 = vtr(kb + vrd + ks * 1024 + 512), b0 = vtr(kb + vrd + 4096 + ks * 1024), b1 = vtr(kb + vrd + 4096 + ks * 1024 + 512);
                    const bf16x8 v0 = (bf16x8){a0[0], a0[1], a0[2], a0[3], a1[0], a1[1], a1[2], a1[3]}, v1 = (bf16x8){b0[0], b0[1], b0[2], b0[3], b1[0], b1[1], b1[2], b1[3]};
                    o0 = __builtin_amdgcn_mfma_f32_32x32x16_bf16(pa[ks], v0, o0, 0, 0, 0); o1 = __builtin_amdgcn_mfma_f32_32x32x16_bf16(pa[ks], v1, o1, 0, 0, 0); }
                if (t + 1 < NT) { LAS unsigned char* nb = kv + ((t + 1) & 1) * 16384; *(LAS v4u*)(nb + kdst) = kr; *(LAS v4u*)(nb + vdst) = vr; }
                mk = mkn;
                __syncthreads();
            }
            l += __shfl_xor(l, 32);
            if (hi == 0) scr[r32] = 1.0f / l;
            LDS_WAIT();
            bf16* orow = AO + (size_t)qw * 512 + h * 64 + r32;
#pragma unroll
            for (int a = 0; a < 4; ++a) { const f32x4 s4 = *(const LAS f32x4*)(scr + 8 * a + 4 * hi);
#pragma unroll
                for (int j = 0; j < 4; ++j) { const int row = 8 * a + 4 * hi + j;
                    orow[(size_t)row * 512] = (bf16)f2bf(o0[4 * a + j] * s4[j]); orow[(size_t)row * 512 + 32] = (bf16)f2bf(o1[4 * a + j] * s4[j]); } }
            LDS_WAIT();
        }
}

__device__ __forceinline__ void ln_row(const float* src, const float* g, const float* b, float* dst, bf16* dstb, int lane) {
    const GAS f32x4* xr = (const GAS f32x4*)src + lane;
    f32x4 v[4]; float s = 0.f;
#pragma unroll
    for (int j = 0; j < 4; ++j) { v[j] = xr[64 * j]; s += (v[j][0] + v[j][1]) + (v[j][2] + v[j][3]); }
    const float mean = wave_sum(s) * (1.f / D); float s2 = 0.f;
#pragma unroll
    for (int j = 0; j < 4; ++j) { v[j] = v[j] - mean; s2 += (v[j][0] * v[j][0] + v[j][1] * v[j][1]) + (v[j][2] * v[j][2] + v[j][3] * v[j][3]); }
    const float rstd = 1.f / sqrtf(wave_sum(s2) * (1.f / D) + LN_EPS);
#pragma unroll
    for (int j = 0; j < 4; ++j) { const f32x4 gg = ((const GAS f32x4*)g)[lane + 64 * j], bb = ((const GAS f32x4*)b)[lane + 64 * j]; const f32x4 y = v[j] * rstd * gg + bb;
        ((GAS f32x4*)dst)[lane + 64 * j] = y;
        if (dstb) { v2u w; w.x = cvt_pk_bf16(y[0], y[1]); w.y = cvt_pk_bf16(y[2], y[3]); ((GAS v2u*)dstb)[lane + 64 * j] = w; } }
}
__device__ __forceinline__ void ph_ln1_router(const Ptrs& P, LAS unsigned char* lds, int G) {
    const int tid = threadIdx.x, lane = tid & 63, wave = __builtin_amdgcn_readfirstlane(tid >> 6);
    const float* H1 = (const float*)(P.ws + WS_H1); float* X1 = (float*)(P.ws + WS_X1); bf16* X1B = (bf16*)(P.ws + WS_X1B);
    int* TOPI = (int*)(P.ws + WS_TOPI); float* TOPG = (float*)(P.ws + WS_TOPG); int* CNTCH = (int*)(P.ws + WS_CNTCH);
    LAS float* part = (LAS float*)lds;
    LAS unsigned* hist = (LAS unsigned*)(lds + 32768);
    for (int ch = blockIdx.x; ch < M / 64; ch += G) {
        for (int i = 0; i < 8; ++i) { const size_t row = (size_t)ch * 64 + wave * 8 + i; ln_row(H1 + row * D, P.ln1_g, P.ln1_b, X1 + row * D, X1B + row * D, lane); }
        if (tid < 32) hist[tid] = 0u;
        VM_WAIT(); __syncthreads();
        const int rg = wave >> 2, kq = wave & 3;
        f32x16 acc;
#pragma unroll
        for (int i = 0; i < 16; ++i) acc[i] = 0.f;
        const float* xrow = X1 + ((size_t)ch * 64 + rg * 32 + (lane & 31)) * D + 4 * (lane >> 5);
        const float* wr = P.w_router + (size_t)(4 * (lane >> 5)) * NE + (lane & 31);
        for (int k0 = kq * 256; k0 < kq * 256 + 256; k0 += 8) {
            const f32x4 xa = *(const GAS f32x4*)(xrow + k0);
#pragma unroll
            for (int i = 0; i < 4; ++i) acc = __builtin_amdgcn_mfma_f32_32x32x2f32(xa[i], wr[(size_t)(k0 + i) * NE], acc, 0, 0, 0);
        }
#pragma unroll
        for (int i = 0; i < 16; ++i) part[(wave * 16 + i) * 64 + lane] = acc[i];
        __syncthreads();
        if (tid < 64) {
            const int r = tid, rgg = r >> 5, rho = r & 31, ii = (rho & 3) + 4 * (rho >> 3), lh = 32 * ((rho >> 2) & 1);
            float lg[NE];
#pragma unroll
            for (int e = 0; e < NE; ++e) { float s = P.b_router[e];
#pragma unroll
                for (int q = 0; q < 4; ++q) s += part[((rgg * 4 + q) * 16 + ii) * 64 + lh + e];
                lg[e] = s; }
            float tv[4]; int ti[4];
#pragma unroll
            for (int s = 0; s < 4; ++s) { float best = -INFINITY; int bi = 0;
#pragma unroll
                for (int e = 0; e < NE; ++e) if (lg[e] > best) { best = lg[e]; bi = e; }
                tv[s] = best; ti[s] = bi;
#pragma unroll
                for (int e = 0; e < NE; ++e) if (e == bi) lg[e] = -INFINITY; }
            const float e1 = __expf(tv[1] - tv[0]), e2 = __expf(tv[2] - tv[0]), e3 = __expf(tv[3] - tv[0]); const float inv = 1.0f / (1.0f + e1 + e2 + e3);
            const size_t row = (size_t)ch * 64 + r;
            *(int4*)(TOPI + row * 4) = make_int4(ti[0], ti[1], ti[2], ti[3]);
            *(float4*)(TOPG + row * 4) = make_float4(inv, e1 * inv, e2 * inv, e3 * inv);
#pragma unroll
            for (int s = 0; s < 4; ++s) atomicAdd((unsigned*)&hist[ti[s]], 1u);
        }
        __syncthreads();
        if (tid < 32) CNTCH[ch * 32 + tid] = (int)hist[tid];
        __syncthreads();
    }
}

__device__ __forceinline__ void ph_dispatch(const Ptrs& P, LAS unsigned char* lds, int G) {
    const int tid = threadIdx.x;
    const int* TOPI = (const int*)(P.ws + WS_TOPI); const float* TOPG = (const float*)(P.ws + WS_TOPG); const int* CNTCH = (const int*)(P.ws + WS_CNTCH);
    int* ROWTOK = (int*)(P.ws + WS_ROWTOK); float* ROWGATE = (float*)(P.ws + WS_ROWGATE); int* TOKPOS = (int*)(P.ws + WS_TOKPOS); int* EXPOFF = (int*)(P.ws + WS_EXPOFF);
    LAS int* redT = (LAS int*)lds;
    LAS int* redB = redT + 512;
    LAS int* offs = redB + 512;
    LAS int* tot = offs + 40;
    LAS int* bel = tot + 32;
    LAS int* el = bel + 32;
    for (int ch = blockIdx.x; ch < M / 64; ch += G) {
        { const int e = tid & 31, part = tid >> 5; int T = 0, B = 0;
            for (int c = part * 16; c < part * 16 + 16; ++c) { const int v = CNTCH[c * 32 + e]; T += v; if (c < ch) B += v; }
            redT[part * 32 + e] = T; redB[part * 32 + e] = B; }
        __syncthreads();
        if (tid < 32) { int T = 0, B = 0; for (int q = 0; q < 16; ++q) { T += redT[q * 32 + tid]; B += redB[q * 32 + tid]; } tot[tid] = T; bel[tid] = B; }
        __syncthreads();
        if (tid == 0) { int o = 0; for (int e = 0; e < NE; ++e) { offs[e] = o; o += (tot[e] + 255) & ~255; } offs[NE] = o; }
        if (tid < 256) el[tid] = TOPI[(size_t)ch * 256 + tid];
        __syncthreads();
        if (tid < 256) { const int e = el[tid]; int rank = 0; for (int j = 0; j < tid; ++j) rank += (el[j] == e) ? 1 : 0;
            const int pos = offs[e] + bel[e] + rank; const int row = ch * 64 + (tid >> 2);
            ROWTOK[pos] = row; ROWGATE[pos] = TOPG[(size_t)ch * 256 + tid]; TOKPOS[(size_t)ch * 256 + tid] = pos; }
        if (ch < NE) { const int e = ch; for (int r = offs[e] + tot[e] + tid; r < offs[e + 1]; r += 512) { ROWTOK[r] = 0; ROWGATE[r] = 0.f; } }
        if (ch == 0 && tid <= NE) EXPOFF[tid] = offs[tid];
        __syncthreads();
    }
}

__device__ __forceinline__ void ph_combine(const Ptrs& P, int G) {
    const int tid = threadIdx.x, lane = tid & 63, wave = __builtin_amdgcn_readfirstlane(tid >> 6);
    const float* X1 = (const float*)(P.ws + WS_X1); const bf16* Y = (const bf16*)(P.ws + WS_Y); const int* TOKPOS = (const int*)(P.ws + WS_TOKPOS);
    float* HH = (float*)(P.ws + WS_HH); bf16* HHB = (bf16*)(P.ws + WS_HHB);
    const int gw = blockIdx.x * NWAVES + wave, NGW = G * NWAVES;
    for (int t = gw; t < M; t += NGW) {
        const int4 pos = *(const int4*)(TOKPOS + (size_t)t * 4);
        const int pp[4] = {pos.x, pos.y, pos.z, pos.w};
#pragma unroll
        for (int j = 0; j < 4; ++j) { f32x4 h = ((const GAS f32x4*)(X1 + (size_t)t * D))[lane + 64 * j] * ALPHA;
#pragma unroll
            for (int s = 0; s < 4; ++s) { const v2u w = ((const GAS v2u*)(Y + (size_t)pp[s] * D))[lane + 64 * j]; h[0] += bflo(w.x); h[1] += bfhi(w.x); h[2] += bflo(w.y); h[3] += bfhi(w.y); }
            ((GAS f32x4*)(HH + (size_t)t * D))[lane + 64 * j] = h;
            v2u o; o.x = cvt_pk_bf16(h[0], h[1]); o.y = cvt_pk_bf16(h[2], h[3]); ((GAS v2u*)(HHB + (size_t)t * D))[lane + 64 * j] = o; }
    }
}

__device__ __forceinline__ void ph_ln2(const Ptrs& P, int G) {
    const int tid = threadIdx.x, lane = tid & 63, wave = __builtin_amdgcn_readfirstlane(tid >> 6);
    const float* V2 = (const float*)(P.ws + WS_V2);
    const int gw = blockIdx.x * NWAVES + wave, NGW = G * NWAVES;
    for (int t = gw; t < M; t += NGW) ln_row(V2 + (size_t)t * D, P.ln2_g, P.ln2_b, P.out + (size_t)t * D, nullptr, lane);
}

constexpr int NPHASE = 15;
struct Args { Ptrs p; int ph_lo, ph_hi; };
__global__ void __launch_bounds__(NWAVES * 64, 2) mk_fwd(Args args) {
    extern __shared__ __attribute__((aligned(16))) unsigned char lds_raw[];
    LAS unsigned char* lds = (LAS unsigned char*)lds_raw;
    volatile LAS unsigned* MISC = (volatile LAS unsigned*)(lds + MISC_OFF);
    const Ptrs& P = args.p; unsigned char* ws = P.ws;
    const int tid = threadIdx.x, G = gridDim.x;
    for (int u = tid; u < (LDS_BYTES - LDSCTL_OFF) / 4; u += NWAVES * 64) ((LAS unsigned*)(lds + LDSCTL_OFF))[u] = 0u;
    __syncthreads();
    const int lo = args.ph_lo, hi = args.ph_hi;
    const bool multi = (hi - lo) > 1;
    XcdBarrier bar; bar.bar = (unsigned*)(ws + WS_CTL) + CW_BAR; bar.x = 0; bar.st = nullptr;
    if (multi) bar = xcd_barrier_post((unsigned*)(ws + WS_CTL) + CW_BAR, MISC + 8);
#ifndef PH_MASK
#define PH_MASK 0x7fff
#endif
#define IN(k) ((((PH_MASK) >> (k)) & 1) && lo <= (k) && (k) < hi)
#define SEAM(k) do { if (IN(k) && IN((k) + 1)) xcd_barrier(bar); } while (0)
    LAS int* expoff = (LAS int*)(lds + LDSCTL_OFF);

    if (IN(0)) { ph_prologue(P, lds, G); SEAM(0); }
    if (IN(1)) {
        pg8::Gemm g{(const bf16*)(ws + WS_XB), (const bf16*)(ws + WS_WIN), M, NPROJ, D}; pg8::StaticOrder S; S.init(M, NPROJ, G, (int)blockIdx.x);
        EpiProj E{ws, (const float*)(ws + WS_BIASP)};
        pg8::gemm_phase<EpiProj, pg8::StaticOrder, true, true>(lds + RING_OFF, g, S, E);
        SEAM(1);
    }
    if (IN(2)) {
#ifndef NO_CONV
        ph_conv(P, lds, G); __syncthreads();
#endif
#ifndef NO_INDEX
#ifdef SLOW_INDEX
        ph_index_slow(P, lds, G);
#else
        ph_index_fast(P, lds, G);
#endif
#endif
        SEAM(2); }
    if (IN(3)) {
#ifdef SLOW_ATTN
        ph_attn_slow(P, G);
#else
        ph_attn_fast(P, lds, G);
#endif
        SEAM(3); }
    if (IN(4)) {
        pg8::Gemm g{(const bf16*)(ws + WS_AO), (const bf16*)(ws + WS_WOA), M, D, AW}; pg8::StaticOrder S; S.init(M, D, G, (int)blockIdx.x);
        EpiGated<false> E{(const bf16*)(ws + WS_SG), 0, nullptr, (bf16*)(ws + WS_T)};
        pg8::gemm_phase<EpiGated<false>, pg8::StaticOrder, true, true>(lds + RING_OFF, g, S, E);
        SEAM(4);
    }
    if (IN(5)) {
        pg8::Gemm g{(const bf16*)(ws + WS_CO), (const bf16*)(ws + WS_WOC), M, D, CCH}; pg8::StaticOrder S; S.init(M, D, G, (int)blockIdx.x);
        EpiGated<true> E{(const bf16*)(ws + WS_SG), 1024, (const bf16*)(ws + WS_T), (bf16*)(ws + WS_MG)};
        pg8::gemm_phase<EpiGated<true>, pg8::StaticOrder, true, true>(lds + RING_OFF, g, S, E);
        SEAM(5);
    }
    if (IN(6)) {
        pg8::Gemm g{(const bf16*)(ws + WS_MG), (const bf16*)(ws + WS_WOUT), M, D, D}; pg8::StaticOrder S; S.init(M, D, G, (int)blockIdx.x);
        EpiRes E{P.x, (float*)(ws + WS_H1)};
        pg8::gemm_phase<EpiRes, pg8::StaticOrder, true, true>(lds + RING_OFF, g, S, E);
        SEAM(6);
    }
    if (IN(7)) { ph_ln1_router(P, lds, G); SEAM(7); }
    if (IN(8)) { ph_dispatch(P, lds, G); SEAM(8); }
    if (IN(9) || IN(10)) { if (tid <= NE) expoff[tid] = ((const int*)(ws + WS_EXPOFF))[tid]; __syncthreads(); }
    if (IN(9)) {
        pg8::Gemm g{(const bf16*)(ws + WS_X1B), (const bf16*)(ws + WS_WGU), RMAX, 2 * DE, D};
        MoeOrder<true> S{expoff, 8, G, (int)blockIdx.x, (const int*)(ws + WS_ROWTOK), D, (size_t)2 * DE * D * 2};
        EpiSwiglu E{(const float*)(ws + WS_BGUP), (bf16*)(ws + WS_HB)};
        pg8::gemm_phase<EpiSwiglu, MoeOrder<true>, true, true>(lds + RING_OFF, g, S, E);
        SEAM(9);
    }
    if (IN(10)) {
        pg8::Gemm g{(const bf16*)(ws + WS_HB), (const bf16*)(ws + WS_WD), RMAX, D, DE};
        MoeOrder<false> S{expoff, 4, G, (int)blockIdx.x, nullptr, DE, (size_t)D * DE * 2};
        EpiDown E{P.b_down, (const float*)(ws + WS_ROWGATE), (bf16*)(ws + WS_Y)};
        pg8::gemm_phase<EpiDown, MoeOrder<false>, true, true>(lds + RING_OFF, g, S, E);
        SEAM(10);
    }
    if (IN(11)) { ph_combine(P, G); SEAM(11); }
    if (IN(12)) {
        pg8::Gemm g{(const bf16*)(ws + WS_PB), (const bf16*)(ws + WS_WPP), M, D, PLE}; pg8::StaticOrder S; S.init(M, D, G, (int)blockIdx.x);
        EpiPlain E{(bf16*)(ws + WS_PP)};
        pg8::gemm_phase<EpiPlain, pg8::StaticOrder, true, true>(lds + RING_OFF, g, S, E);
        SEAM(12);
    }
    if (IN(13)) {
        pg8::Gemm g{(const bf16*)(ws + WS_HHB), (const bf16*)(ws + WS_WPG), M, D, D}; pg8::StaticOrder S; S.init(M, D, G, (int)blockIdx.x);
        EpiPle E{(const float*)(ws + WS_HH), (const bf16*)(ws + WS_PP), (float*)(ws + WS_V2)};
        pg8::gemm_phase<EpiPle, pg8::StaticOrder, true, true>(lds + RING_OFF, g, S, E);
        SEAM(13);
    }
    if (IN(14)) { ph_ln2(P, G); }
#ifdef DBG_OUT
    if (lo == 15) {
        const size_t gt = (size_t)blockIdx.x * (NWAVES * 64) + tid, NT = (size_t)G * NWAVES * 64;
        for (size_t i = gt; i < (size_t)M * D; i += NT) {
#if DBG_OUT == 1
            P.out[i] = ((const float*)(ws + WS_H1))[i];
#elif DBG_OUT == 2
            P.out[i] = bf2f(((const bf16*)(ws + WS_MG))[i]);
#elif DBG_OUT == 3
            { const size_t r = i >> 10, c = i & 1023; P.out[i] = c < 512 ? bf2f(((const bf16*)(ws + WS_AO))[r * 512 + c]) : bf2f(((const bf16*)(ws + WS_CO))[r * 512 + c - 512]); }
#elif DBG_OUT == 4
            { const size_t r = i >> 10, c = i & 1023; P.out[i] = c < 512 ? (float)(((const unsigned*)(ws + WS_MASK))[r * 512 + c] & 0xffffu) : (float)(((const unsigned*)(ws + WS_MASK))[r * 512 + c - 512] >> 16); }
#elif DBG_OUT == 5
            P.out[i] = ((const float*)(ws + WS_HH))[i];
#elif DBG_OUT == 6
            P.out[i] = ((const float*)(ws + WS_X1))[i];
#elif DBG_OUT == 7
            P.out[i] = bf2f(((const bf16*)(ws + WS_T))[i]);
#elif DBG_OUT == 9
            { const size_t r = i >> 10, c = i & 1023; P.out[i] = c < 512 ? bf2f(((const bf16*)(ws + WS_Q))[r * 512 + c]) : bf2f(((const bf16*)(ws + WS_U))[r * 512 + c - 512]); }
#elif DBG_OUT == 10
            { const size_t r = i >> 10, c = i & 1023; P.out[i] = bf2f(((const bf16*)(ws + WS_WIN))[(3072 + (r & 2047)) * 1024 + c]) + ((const float*)(ws + WS_BIASP))[3072 + (i & 2047)]; }
#elif DBG_OUT == 8
            { const size_t r = i >> 10, c = i & 1023; P.out[i] = bf2f(((const bf16*)(ws + WS_SG))[r * 2048 + c]) + 2.f * bf2f(((const bf16*)(ws + WS_SG))[r * 2048 + 1024 + c]); }
#endif
        }
    }
#endif
#undef IN
#undef SEAM
}

#ifndef MK_ONE_LAUNCH
#define MK_ONE_LAUNCH 1
#endif
extern "C" void kernel_launch(void* const* d_in, const int* in_sizes, int n_in, void* d_out, int out_size, void* d_ws, size_t ws_size, hipStream_t stream) {
    static int grid = 0;
    if (grid == 0) {
        if (n_in != 24 || in_sizes[0] != M * D || out_size != M * D || ws_size < WS_END) { fprintf(stderr, "kernel_launch: unexpected shapes (n_in %d, in0 %d, out %d, ws %zu)\n", n_in, n_in > 0 ? in_sizes[0] : -1, out_size, ws_size); grid = -1; return; }
        int dev = 0, cus = 0, per_cu = 0;
        if (hipGetDevice(&dev) != hipSuccess || hipDeviceGetAttribute(&cus, hipDeviceAttributeMultiprocessorCount, dev) != hipSuccess) { grid = -1; return; }
        if (hipFuncSetAttribute((const void*)mk_fwd, hipFuncAttributeMaxDynamicSharedMemorySize, LDS_BYTES) != hipSuccess) { fprintf(stderr, "kernel_launch: hipFuncSetAttribute failed\n"); grid = -1; return; }
        if (hipOccupancyMaxActiveBlocksPerMultiprocessor(&per_cu, (const void*)mk_fwd, NWAVES * 64, LDS_BYTES) != hipSuccess || per_cu < 1) fprintf(stderr, "kernel_launch: occupancy query reports %d\n", per_cu);
        (void)hipGetLastError();
        grid = cus;
    }
    if (grid < 0) return;
    if (hipMemsetAsync((char*)d_ws + WS_CTL, 0, CTL_ZERO_BYTES, stream) != hipSuccess) return;
    Args a{};
    const float** pp = (const float**)&a.p;
    for (int i = 0; i < 24; ++i) pp[i] = (const float*)d_in[i];
    a.p.out = (float*)d_out; a.p.ws = (unsigned char*)d_ws;
#if MK_ONE_LAUNCH
    a.ph_lo = 0; a.ph_hi = NPHASE;
    hipLaunchKernelGGL(mk_fwd, dim3(grid), dim3(NWAVES * 64), LDS_BYTES, stream, a);
#else
#ifndef NRUN
#define NRUN NPHASE
#endif
#ifdef DBG_OUT
    for (int ph = 0; ph <= (DBG_OUT <= 4 ? (DBG_OUT == 1 ? 6 : DBG_OUT == 2 ? 5 : 3) : (DBG_OUT == 5 ? 11 : DBG_OUT == 6 ? 7 : DBG_OUT == 7 ? 4 : 1)); ++ph) { a.ph_lo = ph; a.ph_hi = ph + 1; hipLaunchKernelGGL(mk_fwd, dim3(grid), dim3(NWAVES * 64), LDS_BYTES, stream, a); }
    a.ph_lo = 15; a.ph_hi = 16; hipLaunchKernelGGL(mk_fwd, dim3(grid), dim3(NWAVES * 64), LDS_BYTES, stream, a);
    return;
#endif
    for (int ph = 0; ph < NRUN; ++ph) { a.ph_lo = ph; a.ph_hi = ph + 1; hipLaunchKernelGGL(mk_fwd, dim3(grid), dim3(NWAVES * 64), LDS_BYTES, stream, a); }
#endif
}
```

```cpp
#include <hip/hip_runtime.h>
#include <cstdio>
#include <cstdint>

namespace pg8 {
#define PG8_LAS __attribute__((address_space(3)))
typedef unsigned short bf16_t;
typedef short bf16x8 __attribute__((ext_vector_type(8)));
typedef float f32x4 __attribute__((ext_vector_type(4)));
typedef unsigned u32x4 __attribute__((ext_vector_type(4)));
typedef unsigned u32x2 __attribute__((ext_vector_type(2)));
constexpr int BM = 256, BK = 64, HALF = 128, HTB = HALF * BK * 2  , STAGE_BYTES = 8 * HTB, NXCD = 8, WGM = 8;

__host__ __device__ __forceinline__ int lds_byte(int r, int c) { const int st = (r >> 4) * 2 + (c >> 5), rr = r & 15, cc = c & 31, ob = rr * 64 + cc * 2; return st * 1024 + (ob ^ (((ob >> 9) & 1) << 5)); }
__host__ __device__ __forceinline__ void stage_rc(int b, int& R, int& C) { const int st = b / 1024, sb = b % 1024, swz = sb ^ (((sb >> 9) & 1) << 5); R = (st >> 1) * 16 + swz / 64; C = (st & 1) * 32 + (swz % 64) / 2; }
__host__ __device__ __forceinline__ int perm32(int rho) { const int n = rho >> 4, i = rho & 15; return 8 * (i >> 2) + 4 * n + (i & 3); }

struct Unit { int pm, pn, e; };
struct Gemm { const bf16_t* A; const bf16_t* Bt; int M, N, K; };

struct StaticOrder {
    static constexpr bool GATHER = false;
    int nM, nN, nwg, G, c;
    __host__ __device__ void init(int M, int N, int G_, int c_) { nM = M / BM; nN = N / BM; nwg = nM * nN; G = G_; c = c_; }
    __host__ __device__ bool next(int i, Unit& u) const {
        const long L = (long)i * G + c; if (L >= nwg) return false;
        int wgid = (int)L; { const int q = nwg / NXCD, r = nwg % NXCD, xcd = wgid % NXCD, off = wgid / NXCD; wgid = (xcd < r ? xcd * (q + 1) : r * (q + 1) + (xcd - r) * q) + off; }
        const int nig = WGM * nN, gid = wgid / nig, fm = gid * WGM, gsz = (nM - fm) < WGM ? (nM - fm) : WGM;
        u.pm = fm + ((wgid % nig) % gsz); u.pn = (wgid % nig) / gsz; u.e = 0; return true;
    }
    __device__ __forceinline__ const char* a_base(const Gemm& g, const Unit& u) const { return (const char*)g.A + (size_t)u.pm * ((size_t)BM * g.K * 2); }
    __device__ __forceinline__ const char* b_base(const Gemm& g, const Unit& u) const { return (const char*)g.Bt + (size_t)u.pn * ((size_t)BM * g.K * 2); }
    __device__ __forceinline__ unsigned a_rowoff(const Unit&, int, int) const { return 0u; }
};

typedef float f32x2_cv __attribute__((ext_vector_type(2))); typedef __bf16 bf16x2_cv __attribute__((ext_vector_type(2)));
__device__ __forceinline__ unsigned cvt_pk_bf16(float lo, float hi) { const f32x2_cv v = {lo, hi}; const bf16x2_cv b = __builtin_convertvector(v, bf16x2_cv); return __builtin_bit_cast(unsigned, b); }

template <class Epi, class Sched, bool ALIGN_EPI = false, bool SP2 = false>
__device__ __forceinline__ void gemm_phase(PG8_LAS unsigned char* lds, const Gemm g, const Sched& S, const Epi& E) {
    const int tid = threadIdx.x, wid = __builtin_amdgcn_readfirstlane(tid >> 6), lane = tid & 63, wr = wid >> 2, wc = wid & 3, fr = lane & 15, fq = lane >> 4;
    int K_ = g.K; asm volatile("" : "+s"(K_));
    const int K = K_, nt = K / BK;
    constexpr bool GATHER = Sched::GATHER;
    int Rr[2], Cc[2]; unsigned voffB[2];
#pragma unroll
    for (int i = 0; i < 2; ++i) { stage_rc(tid * 16 + i * 8192, Rr[i], Cc[i]); const int Rb = Epi::PERM ? ((Rr[i] & ~31) + perm32(Rr[i] & 31)) : Rr[i];
        voffB[i] = (unsigned)(Rb * K + Cc[i]) * 2u; }
    const size_t kstep = (size_t)(BK * 2);
    const size_t hstep = (size_t)HALF * K * 2;
    const unsigned ldsw = (unsigned)wid * 1024u;
    const int aoff = lds_byte(wr * 64 + fr, fq * 8), boff = lds_byte(wc * 32 + fr, fq * 8);
    unsigned vA[2][2], vN[2][2];
#define PG8_SETA(v, u) do { _Pragma("unroll") for (int _h = 0; _h < 2; ++_h) _Pragma("unroll") for (int _i = 0; _i < 2; ++_i) \
        v[_h][_i] = (GATHER ? S.a_rowoff(u, _h, Rr[_i]) : (unsigned)((_h * HALF + Rr[_i]) * K) * 2u) + (unsigned)Cc[_i] * 2u; } while (0)
#define PG8_SA(b, h) (((b) * 2 + (h)) * HTB)
#define PG8_SB(b, h) ((4 + (b) * 2 + (h)) * HTB)
#define PG8_STAGE(bufoff, gbase, voff) do { _Pragma("unroll") for (int _i = 0; _i < 2; ++_i) \
        __builtin_amdgcn_global_load_lds((const unsigned*)((const char*)(gbase) + (voff)[_i]), (PG8_LAS unsigned*)(lds + (bufoff) + ldsw + _i * 8192), 16, 0, 0); } while (0)
#define PG8_LDA(dst, b, h) do { _Pragma("unroll") for (int m = 0; m < 4; ++m) _Pragma("unroll") for (int k = 0; k < 2; ++k) dst[m][k] = *(const PG8_LAS bf16x8*)(lds + PG8_SA(b, h) + aoff + m * 2048 + k * 1024); } while (0)
#define PG8_LDB(dst, b, h) do { _Pragma("unroll") for (int n = 0; n < 2; ++n) _Pragma("unroll") for (int k = 0; k < 2; ++k) dst[n][k] = *(const PG8_LAS bf16x8*)(lds + PG8_SB(b, h) + boff + n * 2048 + k * 1024); } while (0)
#define PG8_MMA(ai, bj, At, Bt) do { __builtin_amdgcn_s_setprio(1); _Pragma("unroll") for (int m = 0; m < 4; ++m) _Pragma("unroll") for (int n = 0; n < 2; ++n) _Pragma("unroll") for (int k = 0; k < 2; ++k) \
        acc[ai][bj][m][n] = __builtin_amdgcn_mfma_f32_16x16x32_bf16(Bt[n][k], At[m][k], acc[ai][bj][m][n], 0, 0, 0); __builtin_amdgcn_s_setprio(0); } while (0)
#define PG8_WAIT_V(n) asm volatile("s_waitcnt vmcnt(" #n ")" ::: "memory")
#define PG8_WAIT_L(n) asm volatile("s_waitcnt lgkmcnt(" #n ")" ::: "memory")
#define PG8_BAR __builtin_amdgcn_s_barrier()
#define PG8_SCHED __builtin_amdgcn_sched_barrier(0)
    Unit cur, nxt; int ui = 0;
    if (!S.next(0, cur)) return;
    f32x4 acc[2][2][4][2];
#pragma unroll
    for (int a = 0; a < 2; ++a)
#pragma unroll
        for (int b = 0; b < 2; ++b)
#pragma unroll
            for (int m = 0; m < 4; ++m)
#pragma unroll
                for (int n = 0; n < 2; ++n) acc[a][b][m][n] = (f32x4){0.f, 0.f, 0.f, 0.f};
    bf16x8 At[4][2], B0[2][2], B1[2][2];
    const char* cA = S.a_base(g, cur); const char* cB = S.b_base(g, cur);
    PG8_SETA(vA, cur);
    if constexpr (GATHER) { asm volatile("s_waitcnt vmcnt(0)" ::: "memory"); asm volatile("" : "+v"(vA[0][0]), "+v"(vA[0][1]), "+v"(vA[1][0]), "+v"(vA[1][1])); }
    if constexpr (SP2) {
        PG8_STAGE(PG8_SB(0, 0), cB, voffB); PG8_STAGE(PG8_SB(0, 1), cB + hstep, voffB); PG8_STAGE(PG8_SA(0, 0), cA, vA[0]); PG8_STAGE(PG8_SA(0, 1), cA, vA[1]);
        if (wr == 1) PG8_BAR;
        PG8_WAIT_V(2); PG8_BAR;
        PG8_STAGE(PG8_SB(1, 0), cB + kstep, voffB); PG8_STAGE(PG8_SA(1, 0), cA + kstep, vA[0]); PG8_STAGE(PG8_SB(1, 1), cB + hstep + kstep, voffB);
        PG8_WAIT_V(6); PG8_BAR;
    } else {
        PG8_STAGE(PG8_SB(0, 0), cB, voffB); PG8_STAGE(PG8_SA(0, 0), cA, vA[0]); PG8_STAGE(PG8_SB(0, 1), cB + hstep, voffB); PG8_STAGE(PG8_SA(0, 1), cA, vA[1]);
        if (wr == 1) PG8_BAR;
        PG8_WAIT_V(4); PG8_BAR;
        PG8_STAGE(PG8_SB(1, 0), cB + kstep, voffB); PG8_STAGE(PG8_SA(1, 0), cA + kstep, vA[0]); PG8_STAGE(PG8_SB(1, 1), cB + hstep + kstep, voffB);
        PG8_WAIT_V(6); PG8_BAR;
    }
    for (;;) {
        const bool has_next = S.next(ui + 1, nxt);
        const char* nA = has_next ? S.a_base(g, nxt) : cA; const char* nB = has_next ? S.b_base(g, nxt) : cB;
        if constexpr (GATHER) {
            if (has_next) { PG8_SETA(vN, nxt); asm volatile("s_waitcnt vmcnt(0)" ::: "memory"); asm volatile("" : "+v"(vN[0][0]), "+v"(vN[0][1]), "+v"(vN[1][0]), "+v"(vN[1][1])); }
            else {
#pragma unroll
                for (int _h = 0; _h < 2; ++_h)
#pragma unroll
                    for (int _i = 0; _i < 2; ++_i) vN[_h][_i] = vA[_h][_i]; }
        }
        for (int t = 0; t < nt; t += 2) {
            const bool last = (t == nt - 2);
            const char* a1 = cA + (size_t)(t + 1) * kstep;
            const char* a2 = last ? nA : cA + (size_t)(t + 2) * kstep; const char* b2 = last ? nB : cB + (size_t)(t + 2) * kstep;
            const char* a3 = a2 + kstep; const char* b3 = b2 + kstep;
            unsigned wA[2][2];
#pragma unroll
            for (int _h = 0; _h < 2; ++_h)
#pragma unroll
                for (int _i = 0; _i < 2; ++_i) wA[_h][_i] = GATHER ? (last ? vN[_h][_i] : vA[_h][_i]) : vA[_h][_i];
            if constexpr (SP2) {
            PG8_LDB(B0, 0, 0); PG8_LDB(B1, 0, 1); PG8_SCHED; PG8_LDA(At, 0, 0); PG8_STAGE(PG8_SA(1, 1), a1, vA[1]);
            PG8_WAIT_V(8); PG8_WAIT_L(0); PG8_BAR; PG8_MMA(0, 0, At, B0); PG8_MMA(0, 1, At, B1); PG8_BAR; PG8_SCHED;
            PG8_LDA(At, 0, 1); PG8_STAGE(PG8_SB(0, 0), b2, voffB); PG8_STAGE(PG8_SB(0, 1), b2 + hstep, voffB); PG8_STAGE(PG8_SA(0, 0), a2, wA[0]);
            PG8_WAIT_V(8); PG8_WAIT_L(0); PG8_BAR; PG8_MMA(1, 0, At, B0); PG8_MMA(1, 1, At, B1); PG8_BAR; PG8_SCHED;
            PG8_LDB(B0, 1, 0); PG8_LDB(B1, 1, 1); PG8_SCHED; PG8_LDA(At, 1, 0); PG8_STAGE(PG8_SA(0, 1), a2, wA[1]);
            PG8_WAIT_V(8); PG8_WAIT_L(0); PG8_BAR; PG8_MMA(0, 0, At, B0); PG8_MMA(0, 1, At, B1); PG8_BAR; PG8_SCHED;
            PG8_LDA(At, 1, 1); PG8_STAGE(PG8_SB(1, 0), b3, voffB); PG8_STAGE(PG8_SB(1, 1), b3 + hstep, voffB); PG8_STAGE(PG8_SA(1, 0), a3, wA[0]);
            PG8_WAIT_V(8); PG8_WAIT_L(0); PG8_BAR; PG8_MMA(1, 0, At, B0); PG8_MMA(1, 1, At, B1); PG8_BAR; PG8_SCHED;
            } else {
            PG8_LDB(B0, 0, 0); PG8_SCHED; PG8_LDA(At, 0, 0); PG8_STAGE(PG8_SA(1, 1), a1, vA[1]);
            PG8_WAIT_L(8); PG8_BAR; PG8_WAIT_L(0); PG8_MMA(0, 0, At, B0); PG8_BAR; PG8_SCHED;
            PG8_LDB(B1, 0, 1); PG8_STAGE(PG8_SB(0, 0), b2, voffB);
            PG8_BAR; PG8_WAIT_L(0); PG8_MMA(0, 1, At, B1); PG8_BAR;
            PG8_LDA(At, 0, 1); PG8_STAGE(PG8_SA(0, 0), a2, wA[0]);
            PG8_BAR; PG8_WAIT_L(0); PG8_MMA(1, 0, At, B0); PG8_BAR; PG8_SCHED;
            PG8_STAGE(PG8_SB(0, 1), b2 + hstep, voffB);
            PG8_WAIT_V(6); PG8_BAR; PG8_MMA(1, 1, At, B1); PG8_BAR;
            PG8_LDB(B0, 1, 0); PG8_SCHED; PG8_LDA(At, 1, 0); PG8_STAGE(PG8_SA(0, 1), a2, wA[1]);
            PG8_WAIT_L(8); PG8_BAR; PG8_WAIT_L(0); PG8_MMA(0, 0, At, B0); PG8_BAR; PG8_SCHED;
            PG8_LDB(B1, 1, 1); PG8_STAGE(PG8_SB(1, 0), b3, voffB);
            PG8_BAR; PG8_WAIT_L(0); PG8_MMA(0, 1, At, B1); PG8_BAR;
            PG8_LDA(At, 1, 1); PG8_STAGE(PG8_SA(1, 0), a3, wA[0]);
            PG8_BAR; PG8_WAIT_L(0); PG8_MMA(1, 0, At, B0); PG8_BAR; PG8_SCHED;
            PG8_STAGE(PG8_SB(1, 1), b3 + hstep, voffB);
            PG8_WAIT_V(6); PG8_BAR; PG8_MMA(1, 1, At, B1); PG8_BAR;
            }
        }
        if constexpr (ALIGN_EPI) { if (wr == 0) PG8_BAR; }
        E(acc, cur, wr, wc, fr, fq);
        if (!has_next) break;
#pragma unroll
        for (int a = 0; a < 2; ++a)
#pragma unroll
            for (int b = 0; b < 2; ++b)
#pragma unroll
                for (int m = 0; m < 4; ++m)
#pragma unroll
                    for (int n = 0; n < 2; ++n) acc[a][b][m][n] = (f32x4){0.f, 0.f, 0.f, 0.f};
        cur = nxt; cA = nA; cB = nB; ++ui;
#pragma unroll
        for (int _h = 0; _h < 2; ++_h)
#pragma unroll
            for (int _i = 0; _i < 2; ++_i) vA[_h][_i] = GATHER ? vN[_h][_i] : vA[_h][_i];
        if constexpr (ALIGN_EPI) { if (wr == 1) PG8_BAR; }
    }
    PG8_WAIT_V(0);
    if constexpr (!ALIGN_EPI) { if (wr == 0) PG8_BAR; }
    PG8_BAR;
#undef PG8_SETA
#undef PG8_SA
#undef PG8_SB
#undef PG8_STAGE
#undef PG8_LDA
#undef PG8_LDB
#undef PG8_MMA
#undef PG8_WAIT_V
#undef PG8_WAIT_L
#undef PG8_BAR
#undef PG8_SCHED
}
}

constexpr int NWAVES = 8;
constexpr int M = 16384, D = 1024, AW = 512, NH = 8, HD = 64, CCH = 512, CWID = 31, NE = 32, DE = 1024, PLE = 256;
constexpr int IN_COLS = 5192, NPROJ = 5376;
constexpr float LN_EPS = 1e-5f;
constexpr float ALPHA = 1.18920711500272f;
constexpr float LOG2E = 1.4426950408889634f;
constexpr float C2 = 0.125f * LOG2E;
constexpr int RMAX = 73728;
constexpr int TOPK = 256;

constexpr size_t MiB = 1u << 20;
constexpr size_t WS_CTL = 0, CTL_ZERO_BYTES = 1 * MiB;
constexpr size_t WS_SMALL = 1 * MiB;
constexpr size_t WS_BIASP = WS_SMALL;
constexpr size_t WS_BGUP = WS_SMALL + 32 * 1024;
constexpr size_t WS_RT = WS_SMALL + 320 * 1024;
constexpr size_t WS_EXPOFF = WS_SMALL + 328 * 1024;
constexpr size_t WS_CNTCH = WS_SMALL + 332 * 1024;
constexpr size_t WS_WIN = 2 * MiB;
constexpr size_t WS_WOA = 13 * MiB, WS_WOC = 14 * MiB, WS_WOUT = 15 * MiB, WS_WPG = 17 * MiB, WS_WPP = 19 * MiB;
constexpr size_t WS_WGU = 20 * MiB;
constexpr size_t WS_WD = 148 * MiB;
constexpr size_t WS_XB = 212 * MiB;
constexpr size_t WS_Q = 252 * MiB, WS_K = 268 * MiB, WS_V = 284 * MiB, WS_QI = 300 * MiB;
constexpr size_t WS_KI = 316 * MiB;
constexpr size_t WS_WI = 318 * MiB;
constexpr size_t WS_U = 319 * MiB;
constexpr size_t WS_SG = 335 * MiB;
constexpr size_t WS_MASK = 399 * MiB;
constexpr size_t WS_AO = 431 * MiB, WS_CO = 447 * MiB;
constexpr size_t WS_T = 463 * MiB, WS_MG = 495 * MiB;
constexpr size_t WS_H1 = 527 * MiB;
constexpr size_t WS_X1 = 591 * MiB;
constexpr size_t WS_X1B = 655 * MiB;
constexpr size_t WS_ROUTE = 687 * MiB;
constexpr size_t WS_TOPI = WS_ROUTE, WS_TOPG = WS_ROUTE + 256 * 1024, WS_TOKPOS = WS_ROUTE + 512 * 1024, WS_ROWTOK = WS_ROUTE + 768 * 1024, WS_ROWGATE = WS_ROUTE + 1088 * 1024;
constexpr size_t WS_PP = 689 * MiB;
constexpr size_t WS_PB = 721 * MiB;
constexpr size_t WS_END = 729 * MiB;
constexpr size_t WS_HB = 212 * MiB;
constexpr size_t WS_Y = 356 * MiB;
constexpr size_t WS_HH = WS_H1;
constexpr size_t WS_HHB = WS_X1B;
constexpr size_t WS_V2 = WS_X1;
static_assert(WS_HB + (size_t)RMAX * 1024 * 2 <= WS_Y && WS_Y + (size_t)RMAX * 1024 * 2 <= WS_H1, "overlay map");
static_assert(WS_ROWGATE + RMAX * 4 <= WS_PP, "route map");

constexpr int CW_TMO = 0;
constexpr int CW_BAR = 4096;

constexpr int RING_OFF = 0, RING_BYTES = 131072;
constexpr int LDSCTL_OFF = 143360, MISC_OFF = LDSCTL_OFF + 320;
constexpr int LDS_BYTES = 147456;
static_assert(MISC_OFF + 128 <= LDS_BYTES, "LDS map");

#define GAS __attribute__((address_space(1)))
#define LAS __attribute__((address_space(3)))
typedef unsigned short bf16;
typedef unsigned v4u __attribute__((ext_vector_type(4)));
typedef unsigned v2u __attribute__((ext_vector_type(2)));
typedef float f32x4 __attribute__((ext_vector_type(4)));
typedef float f32x16 __attribute__((ext_vector_type(16)));
typedef short bf16x8 __attribute__((ext_vector_type(8)));
typedef GAS unsigned gu32;
typedef GAS unsigned long long gu64;
#define RLX_AGENT __ATOMIC_RELAXED, __HIP_MEMORY_SCOPE_AGENT
#define LDS_WAIT() asm volatile("s_waitcnt lgkmcnt(0)" ::: "memory")
#define VM_WAIT() asm volatile("s_waitcnt vmcnt(0)" ::: "memory")
__device__ __forceinline__ unsigned f2bf(float f) { unsigned u = __builtin_bit_cast(unsigned, f); return (u + 0x7fffu + ((u >> 16) & 1u)) >> 16; }
__device__ __forceinline__ float bf2f(unsigned b) { return __builtin_bit_cast(float, b << 16); }
__device__ __forceinline__ float bflo(unsigned w) { return __builtin_bit_cast(float, w << 16); }
__device__ __forceinline__ float bfhi(unsigned w) { return __builtin_bit_cast(float, w & 0xffff0000u); }
__device__ __forceinline__ float sigmoidf_(float x) { return __builtin_amdgcn_rcpf(1.0f + __builtin_amdgcn_exp2f(-LOG2E * x)); }
__device__ __forceinline__ LAS unsigned char* lds_opaque(LAS unsigned char* p) { unsigned a = (unsigned)(unsigned long)p; asm volatile("" : "+v"(a)); return (LAS unsigned char*)(unsigned long)a; }
__device__ __forceinline__ unsigned pk2(float lo, float hi) { return f2bf(lo) | (f2bf(hi) << 16); }

#define XB_TMO      128
#define XB_XCNT(j)  (256  + 64 * (j))
#define XB_XSUB(j)  (1280 + 64 * (j))
#define XB_XGEN(j)  (2304 + 64 * (j))
#define XB_TOP      3328
#define XB_TOPGEN   3392
#define XCD_BAR_WORDS 3456
#define XB_SPIN_CAP (1u << 18)

__device__ __forceinline__ unsigned xb_ld(unsigned* p)              { return __hip_atomic_load(p, __ATOMIC_RELAXED, __HIP_MEMORY_SCOPE_AGENT); }
__device__ __forceinline__ unsigned xb_add(unsigned* p, unsigned v) { return __hip_atomic_fetch_add(p, v, __ATOMIC_RELAXED, __HIP_MEMORY_SCOPE_AGENT); }
__device__ __forceinline__ unsigned xb_xcc_id() { return (unsigned)__builtin_amdgcn_s_getreg((3 << 11) | 20) & 0xFu; }
#define XB_SPIN(cond, bar) do { unsigned _sp = 0; while (cond) { __builtin_amdgcn_s_sleep(1); \
    if ((++_sp & 255u) == 0u) { if (xb_ld(&(bar)[XB_TMO])) break; if (_sp > XB_SPIN_CAP) { atomicAdd(&(bar)[XB_TMO], 1u); break; } } } } while (0)

struct XcdBarrier {
    unsigned* bar; unsigned x;
    volatile LAS unsigned* st;
};

__device__ __forceinline__ XcdBarrier xcd_barrier_post(unsigned* bar, volatile LAS unsigned* st) {
    XcdBarrier b; b.bar = bar; b.x = xb_xcc_id(); b.st = st;
    if (threadIdx.x == 0) (void)xb_add(&bar[XB_XCNT(b.x)], 1u);
    return b;
}
__device__ __forceinline__ void xcd_barrier_complete(unsigned* bar, unsigned x, unsigned& nloc, unsigned& nx) {
    const unsigned G = gridDim.x * gridDim.y * gridDim.z;
    unsigned sum, cnt, mine, sp = 0u;
    for (;;) {
        sum = 0u; cnt = 0u; mine = 0u;
#pragma unroll
        for (unsigned j = 0; j < 16; ++j) { const unsigned c = xb_ld(&bar[XB_XCNT(j)]); sum += c; cnt += (c > 0u) ? 1u : 0u; mine = (j == x) ? c : mine; }
        if (sum == G) break;
        __builtin_amdgcn_s_sleep(1);
        if ((++sp & 255u) == 0u) { if (xb_ld(&bar[XB_TMO])) break; if (sp > XB_SPIN_CAP) { atomicAdd(&bar[XB_TMO], 1u); break; } }
    }
    nloc = mine > 0u ? mine : 1u; nx = cnt > 0u ? cnt : 1u;
}

__device__ __forceinline__ void xcd_barrier(const XcdBarrier& b) {
    asm volatile("s_waitcnt vmcnt(0)" ::: "memory");
    __syncthreads();
    if (threadIdx.x == 0) {
        unsigned* bar = b.bar;
        __builtin_amdgcn_s_waitcnt(0);
        unsigned nloc = b.st[0], nx = b.st[1];
        if (nloc == 0u) { xcd_barrier_complete(bar, b.x, nloc, nx); b.st[0] = nloc; b.st[1] = nx; }
        const unsigned old = xb_add(&bar[XB_XSUB(b.x)], 1u);
        const unsigned gen = old / nloc;
        if (old + 1u == (gen + 1u) * nloc) {
            __builtin_amdgcn_fence(__ATOMIC_RELEASE, "agent");
            asm volatile("s_waitcnt vmcnt(0)" ::: "memory");
            const unsigned og = xb_add(&bar[XB_TOP], 1u);
            const unsigned tg = og / nx;
            if (og + 1u == (tg + 1u) * nx) xb_add(&bar[XB_TOPGEN], 1u);
            else XB_SPIN(xb_ld(&bar[XB_TOPGEN]) == tg, bar);
            __builtin_amdgcn_fence(__ATOMIC_ACQUIRE, "agent");
            xb_add(&bar[XB_XGEN(b.x)], 1u);
            asm volatile("s_waitcnt vmcnt(0)" ::: "memory");
        } else {
            XB_SPIN(xb_ld(&bar[XB_XGEN(b.x)]) == gen, bar);
            __builtin_amdgcn_fence(__ATOMIC_ACQUIRE, "agent");
            asm volatile("s_waitcnt vmcnt(0)" ::: "memory");
        }
    }
    __syncthreads();
}


__device__ __forceinline__ float wave_sum(float v) {
#pragma unroll
    for (int o = 1; o < 64; o <<= 1) v += __shfl_xor(v, o);
    return v;
}
__device__ __forceinline__ unsigned f2key(float f) { const unsigned u = __builtin_bit_cast(unsigned, f); return (u & 0x80000000u) ? ~u : (u | 0x80000000u); }
__device__ __forceinline__ int map_in(int n) {
    if (n < 2048) return n;
    if (n < 2112) return 5120 + (n - 2048);
    if (n < 2120) return 5184 + (n - 2112);
    if (n < 2632) { const int c = n - 2120; return 2048 + 8 * (c >> 2) + (c & 3); }
    if (n < 3144) { const int c = n - 2632; return 2048 + 8 * (c >> 2) + 4 + (c & 3); }
    return 3072 + (n - 3144);
}
__device__ __forceinline__ int map_gu(int n) { const int c = n & 1023; return 8 * (c >> 2) + ((n >> 10) << 2) + (c & 3); }
__device__ __forceinline__ int map_id(int n) { return n; }

template <class MapF>
__device__ __forceinline__ void transpose_item(const float* W, int K, int N, bf16* WT, LAS float* scr, int item, int lane, MapF map) {
    const int nblk = (N + 31) / 32, kb = item / nblk, nb = item % nblk, k0 = 64 * kb, n0 = 32 * nb;
    const int nn = n0 + (lane & 31);
#pragma unroll 8
    for (int i = 0; i < 32; ++i) { const int kk = 2 * i + (lane >> 5); scr[kk * 33 + (lane & 31)] = nn < N ? W[(size_t)(k0 + kk) * N + nn] : 0.f; }
    LDS_WAIT(); asm volatile("" ::: "memory");
    const int c = lane & 7;
#pragma unroll
    for (int j = 0; j < 4; ++j) { const int nl = (lane >> 3) + 8 * j; const LAS float* s = scr + (8 * c) * 33 + nl;
        v4u o; o.x = pk2(s[0 * 33], s[1 * 33]); o.y = pk2(s[2 * 33], s[3 * 33]); o.z = pk2(s[4 * 33], s[5 * 33]); o.w = pk2(s[6 * 33], s[7 * 33]);
        if (n0 + nl < N) *(GAS v4u*)(WT + (size_t)map(n0 + nl) * K + k0 + 8 * c) = o; }
    LDS_WAIT(); asm volatile("" ::: "memory");
}

struct Ptrs {
    const float *x, *p, *w_in, *b_in, *w_o_attn, *w_dw, *b_dw, *conv_ln_g, *conv_ln_b, *w_o_conv, *w_out, *ln1_g, *ln1_b, *w_router, *b_router, *w_gate_up, *b_gate_up, *w_down, *b_down,
        *w_ple_gate, *w_ple_proj, *ln2_g, *ln2_b, *rel_bias;
    float* out; unsigned char* ws;
};

__device__ __forceinline__ void ph_prologue(const Ptrs& P, LAS unsigned char* lds, int G) {
    const int tid = threadIdx.x, lane = tid & 63, wave = __builtin_amdgcn_readfirstlane(tid >> 6);
    unsigned char* ws = P.ws;
    LAS float* scr = (LAS float*)(lds + RING_OFF + wave * 16384);
    const int gw = blockIdx.x * NWAVES + wave, NGW = G * NWAVES;
    constexpr int I_IN = 16 * 163, I_OA = 8 * 32, I_OC = 8 * 32, I_OUT = 16 * 32, I_PG = 16 * 32, I_PP = 4 * 32, I_GU1 = 16 * 64, I_D1 = 16 * 32;
    constexpr int NITEMS = I_IN + I_OA + I_OC + I_OUT + I_PG + I_PP + NE * I_GU1 + NE * I_D1;
    for (int it = gw; it < NITEMS; it += NGW) {
        int r = it;
        if (r < I_IN) { transpose_item(P.w_in, D, IN_COLS, (bf16*)(ws + WS_WIN), scr, r, lane, map_in); continue; } r -= I_IN;
        if (r < I_OA) { transpose_item(P.w_o_attn, AW, D, (bf16*)(ws + WS_WOA), scr, r, lane, map_id); continue; } r -= I_OA;
        if (r < I_OC) { transpose_item(P.w_o_conv, CCH, D, (bf16*)(ws + WS_WOC), scr, r, lane, map_id); continue; } r -= I_OC;
        if (r < I_OUT) { transpose_item(P.w_out, D, D, (bf16*)(ws + WS_WOUT), scr, r, lane, map_id); continue; } r -= I_OUT;
        if (r < I_PG) { transpose_item(P.w_ple_gate, D, D, (bf16*)(ws + WS_WPG), scr, r, lane, map_id); continue; } r -= I_PG;
        if (r < I_PP) { transpose_item(P.w_ple_proj, PLE, D, (bf16*)(ws + WS_WPP), scr, r, lane, map_id); continue; } r -= I_PP;
        if (r < NE * I_GU1) { const int e = r / I_GU1; transpose_item(P.w_gate_up + (size_t)e * D * 2 * DE, D, 2 * DE, (bf16*)(ws + WS_WGU) + (size_t)e * 2 * DE * D, scr, r % I_GU1, lane, map_gu); continue; } r -= NE * I_GU1;
        { const int e = r / I_D1; transpose_item(P.w_down + (size_t)e * DE * D, DE, D, (bf16*)(ws + WS_WD) + (size_t)e * D * DE, scr, r % I_D1, lane, map_id); }
    }
    const size_t gt = (size_t)blockIdx.x * (NWAVES * 64) + tid, NT = (size_t)G * NWAVES * 64;
    for (size_t i = gt; i < (size_t)M * D / 8; i += NT) { const f32x4 a = ((const GAS f32x4*)P.x)[2 * i], b = ((const GAS f32x4*)P.x)[2 * i + 1];
        v4u o; o.x = pk2(a.x, a.y); o.y = pk2(a.z, a.w); o.z = pk2(b.x, b.y); o.w = pk2(b.z, b.w); ((GAS v4u*)(ws + WS_XB))[i] = o; }
    for (size_t i = gt; i < (size_t)M * PLE / 8; i += NT) { const f32x4 a = ((const GAS f32x4*)P.p)[2 * i], b = ((const GAS f32x4*)P.p)[2 * i + 1];
        v4u o; o.x = pk2(a.x, a.y); o.y = pk2(a.z, a.w); o.z = pk2(b.x, b.y); o.w = pk2(b.z, b.w); ((GAS v4u*)(ws + WS_PB))[i] = o; }
    float* biasp = (float*)(ws + WS_BIASP); float* bgup = (float*)(ws + WS_BGUP); float* rt = (float*)(ws + WS_RT);
    for (size_t i = gt; i < (size_t)IN_COLS; i += NT) biasp[map_in((int)i)] = P.b_in[i];
    for (size_t i = gt; i < (size_t)NE * 2 * DE; i += NT) { const int e = (int)(i >> 11), n = (int)(i & 2047); bgup[e * 2048 + map_gu(n)] = P.b_gate_up[i]; }
    for (size_t i = gt; i < (size_t)NH * 128; i += NT) { const int h = (int)(i >> 7), rel = (int)(i & 127);
        int bkt; if (rel < 16) bkt = rel; else { bkt = 16 + (int)(logf((float)rel * (1.0f / 16.0f)) / logf(8.0f) * 16.0f); bkt = bkt > 31 ? 31 : bkt; }
        rt[h * 128 + rel] = P.rel_bias[bkt * NH + h] * LOG2E; }
}

using pg8::Unit; using pg8::cvt_pk_bf16; using pg8::HALF; using pg8::BM;
__device__ __forceinline__ v4u pack8(const f32x4& a, const f32x4& b) { v4u w; w.x = cvt_pk_bf16(a[0], a[1]); w.y = cvt_pk_bf16(a[2], a[3]); w.z = cvt_pk_bf16(b[0], b[1]); w.w = cvt_pk_bf16(b[2], b[3]); return w; }
__device__ __forceinline__ f32x4 sig4(const f32x4& a) { f32x4 r; r[0] = sigmoidf_(a[0]); r[1] = sigmoidf_(a[1]); r[2] = sigmoidf_(a[2]); r[3] = sigmoidf_(a[3]); return r; }
__device__ __forceinline__ void unpack8(const v4u w, f32x4& a, f32x4& b) { a[0] = bflo(w.x); a[1] = bfhi(w.x); a[2] = bflo(w.y); a[3] = bfhi(w.y); b[0] = bflo(w.z); b[1] = bfhi(w.z); b[2] = bflo(w.w); b[3] = bfhi(w.w); }

struct EpiProj {
    static constexpr bool PERM = true;
    unsigned char* ws; const float* biasp;
    __device__ __forceinline__ void operator()(const f32x4 (&acc)[2][2][4][2], const Unit& u, int wr, int wc, int fr, int fq) const {
        const int row0 = u.pm * BM + wr * 64 + fr, cl0 = wc * 32 + 8 * fq, pn = u.pn;
        f32x4 bv[2][2];
#pragma unroll
        for (int bj = 0; bj < 2; ++bj)
#pragma unroll
            for (int n = 0; n < 2; ++n) bv[bj][n] = *(const f32x4*)(biasp + pn * BM + cl0 + bj * HALF + 4 * n);
#pragma unroll
        for (int ai = 0; ai < 2; ++ai)
#pragma unroll
            for (int m = 0; m < 4; ++m) { const size_t row = (size_t)(row0 + ai * HALF + m * 16);
#pragma unroll
                for (int bj = 0; bj < 2; ++bj) { f32x4 v0 = acc[ai][bj][m][0] + bv[bj][0], v1 = acc[ai][bj][m][1] + bv[bj][1]; const int cl = cl0 + bj * HALF;
                    if (pn < 8) { const int t = pn >> 1; if (t == 0) { v0 = v0 * C2; v1 = v1 * C2; }
                        bf16* base = (bf16*)(ws + WS_Q + (size_t)t * (WS_K - WS_Q)); *(v4u*)(base + row * 512 + (pn & 1) * 256 + cl) = pack8(v0, v1); }
                    else if (pn < 12) { const f32x4 s = sig4(v1); v2u w; w.x = cvt_pk_bf16(v0[0] * s[0], v0[1] * s[1]); w.y = cvt_pk_bf16(v0[2] * s[2], v0[3] * s[3]);
                        *(v2u*)((bf16*)(ws + WS_U) + row * 512 + (pn - 8) * 128 + (cl >> 1)) = w; }
                    else if (pn < 20) { *(v4u*)((bf16*)(ws + WS_SG) + row * 2048 + (pn - 12) * 256 + cl) = pack8(sig4(v0), sig4(v1)); }
                    else { if (cl < 64) *(v4u*)((bf16*)(ws + WS_KI) + (row >> 5) * 2048 + (cl >> 4) * 512 + (((cl >> 3) & 1) * 32 + (row & 31)) * 8) = pack8(v0, v1);
                           else if (cl == 64) { float* wi = (float*)(ws + WS_WI) + row * 8; *(f32x4*)wi = v0; *(f32x4*)(wi + 4) = v1; } }
                } }
    }
};
template <bool ADD> struct EpiGated {
    static constexpr bool PERM = true;
    const bf16* G; int goff; const bf16* T; bf16* O;
    __device__ __forceinline__ void operator()(const f32x4 (&acc)[2][2][4][2], const Unit& u, int wr, int wc, int fr, int fq) const {
        const int row0 = u.pm * BM + wr * 64 + fr, col0 = u.pn * BM + wc * 32 + 8 * fq;
#pragma unroll
        for (int ai = 0; ai < 2; ++ai)
#pragma unroll
            for (int m = 0; m < 4; ++m) { const size_t row = (size_t)(row0 + ai * HALF + m * 16);
#pragma unroll
                for (int bj = 0; bj < 2; ++bj) { const int col = col0 + bj * HALF; f32x4 g0, g1; unpack8(*(const v4u*)(G + row * 2048 + goff + col), g0, g1);
                    f32x4 v0 = acc[ai][bj][m][0] * g0, v1 = acc[ai][bj][m][1] * g1;
                    if (ADD) { f32x4 t0, t1; unpack8(*(const v4u*)(T + row * 1024 + col), t0, t1); v0 = v0 + t0; v1 = v1 + t1; }
                    *(v4u*)(O + row * 1024 + col) = pack8(v0, v1); } }
    }
};
struct EpiRes {
    static constexpr bool PERM = false;
    const float* X; float* O;
    __device__ __forceinline__ void operator()(const f32x4 (&acc)[2][2][4][2], const Unit& u, int wr, int wc, int fr, int fq) const {
        const int row0 = u.pm * BM + wr * 64 + fr, col0 = u.pn * BM + wc * 32 + 4 * fq;
#pragma unroll
        for (int ai = 0; ai < 2; ++ai)
#pragma unroll
            for (int m = 0; m < 4; ++m) { const size_t off = (size_t)(row0 + ai * HALF + m * 16) * D + col0;
#pragma unroll
                for (int bj = 0; bj < 2; ++bj)
#pragma unroll
                    for (int n = 0; n < 2; ++n) { const f32x4 xv = *(const f32x4*)(X + off + bj * HALF + n * 16); *(f32x4*)(O + off + bj * HALF + n * 16) = xv * ALPHA + acc[ai][bj][m][n]; }
                asm volatile("" ::: "memory"); }
    }
};
struct EpiSwiglu {
    static constexpr bool PERM = true;
    const float* bgup; bf16* HB;
    __device__ __forceinline__ void operator()(const f32x4 (&acc)[2][2][4][2], const Unit& u, int wr, int wc, int fr, int fq) const {
        const int row0 = u.pm * BM + wr * 64 + fr, cl0 = u.pn * BM + wc * 32 + 8 * fq;
        f32x4 bv[2][2];
#pragma unroll
        for (int bj = 0; bj < 2; ++bj)
#pragma unroll
            for (int n = 0; n < 2; ++n) bv[bj][n] = *(const f32x4*)(bgup + u.e * 2048 + cl0 + bj * HALF + 4 * n);
#pragma unroll
        for (int ai = 0; ai < 2; ++ai)
#pragma unroll
            for (int m = 0; m < 4; ++m) { const size_t row = (size_t)(row0 + ai * HALF + m * 16);
#pragma unroll
                for (int bj = 0; bj < 2; ++bj) { const f32x4 g = acc[ai][bj][m][0] + bv[bj][0], uu = acc[ai][bj][m][1] + bv[bj][1]; float a[4];
#pragma unroll
                    for (int j = 0; j < 4; ++j) { const float gg = fminf(g[j], 7.0f), uc = fminf(fmaxf(uu[j], -7.0f), 7.0f); a[j] = (uc + 1.0f) * gg * sigmoidf_(1.702f * gg); }
                    v2u w; w.x = cvt_pk_bf16(a[0], a[1]); w.y = cvt_pk_bf16(a[2], a[3]);
                    *(v2u*)(HB + row * 1024 + ((cl0 + bj * HALF) >> 1)) = w; } }
    }
};
struct EpiDown {
    static constexpr bool PERM = true;
    const float* bd; const float* rowgate; bf16* Y;
    __device__ __forceinline__ void operator()(const f32x4 (&acc)[2][2][4][2], const Unit& u, int wr, int wc, int fr, int fq) const {
        const int row0 = u.pm * BM + wr * 64 + fr, col0 = u.pn * BM + wc * 32 + 8 * fq;
        f32x4 bv[2][2];
#pragma unroll
        for (int bj = 0; bj < 2; ++bj)
#pragma unroll
            for (int n = 0; n < 2; ++n) bv[bj][n] = *(const f32x4*)(bd + u.e * 1024 + col0 + bj * HALF + 4 * n);
#pragma unroll
        for (int ai = 0; ai < 2; ++ai)
#pragma unroll
            for (int m = 0; m < 4; ++m) { const size_t row = (size_t)(row0 + ai * HALF + m * 16); const float gt = rowgate[row];
#pragma unroll
                for (int bj = 0; bj < 2; ++bj) *(v4u*)(Y + row * 1024 + col0 + bj * HALF) = pack8((acc[ai][bj][m][0] + bv[bj][0]) * gt, (acc[ai][bj][m][1] + bv[bj][1]) * gt); }
    }
};
struct EpiPlain {
    static constexpr bool PERM = true;
    bf16* O;
    __device__ __forceinline__ void operator()(const f32x4 (&acc)[2][2][4][2], const Unit& u, int wr, int wc, int fr, int fq) const {
        const int row0 = u.pm * BM + wr * 64 + fr, col0 = u.pn * BM + wc * 32 + 8 * fq;
#pragma unroll
        for (int ai = 0; ai < 2; ++ai)
#pragma unroll
            for (int m = 0; m < 4; ++m) { const size_t row = (size_t)(row0 + ai * HALF + m * 16);
#pragma unroll
                for (int bj = 0; bj < 2; ++bj) *(v4u*)(O + row * 1024 + col0 + bj * HALF) = pack8(acc[ai][bj][m][0], acc[ai][bj][m][1]); }
    }
};
struct EpiPle {
    static constexpr bool PERM = false;
    const float* HH; const bf16* PP; float* O;
    __device__ __forceinline__ void operator()(const f32x4 (&acc)[2][2][4][2], const Unit& u, int wr, int wc, int fr, int fq) const {
        const int row0 = u.pm * BM + wr * 64 + fr, col0 = u.pn * BM + wc * 32 + 4 * fq;
#pragma unroll
        for (int ai = 0; ai < 2; ++ai)
#pragma unroll
            for (int m = 0; m < 4; ++m) { const size_t off = (size_t)(row0 + ai * HALF + m * 16) * D + col0;
#pragma unroll
                for (int bj = 0; bj < 2; ++bj)
#pragma unroll
                    for (int n = 0; n < 2; ++n) { const size_t o = off + bj * HALF + n * 16; const f32x4 hv = *(const f32x4*)(HH + o); const v2u pw = *(const v2u*)(PP + o);
                        f32x4 pp; pp[0] = bflo(pw.x); pp[1] = bfhi(pw.x); pp[2] = bflo(pw.y); pp[3] = bfhi(pw.y);
                        *(f32x4*)(O + o) = hv + sig4(acc[ai][bj][m][n]) * pp; }
                asm volatile("" ::: "memory"); }
    }
};

template <bool GATH> struct MoeOrder {
    static constexpr bool GATHER = GATH;
    const LAS int* off; int NT, G, c; const int* rowtok; int K; size_t bstride;
    __device__ __forceinline__ bool next(int i, Unit& u) const {
        int L = i * G + c, cum = 0;
        for (int e = 0; e < NE; ++e) { const int tiles = (off[e + 1] - off[e]) >> 8, nu = tiles * NT;
            if (L < cum + nu) { const int loc = L - cum; u.e = e; u.pm = (off[e] >> 8) + loc % tiles; u.pn = loc / tiles; return true; }
            cum += nu; }
        return false;
    }
    __device__ __forceinline__ const char* a_base(const pg8::Gemm& g, const Unit& u) const { return GATH ? (const char*)g.A : (const char*)g.A + (size_t)u.pm * ((size_t)BM * g.K * 2); }
    __device__ __forceinline__ const char* b_base(const pg8::Gemm& g, const Unit& u) const { return (const char*)g.Bt + (size_t)u.e * bstride + (size_t)u.pn * ((size_t)BM * g.K * 2); }
    __device__ __forceinline__ unsigned a_rowoff(const Unit& u, int h, int R) const { return (unsigned)rowtok[u.pm * BM + h * HALF + R] * (unsigned)(K * 2); }
};

__device__ __forceinline__ void ph_conv(const Ptrs& P, LAS unsigned char* lds, int G) {
    const int tid = threadIdx.x, lane = tid & 63, wave = __builtin_amdgcn_readfirstlane(tid >> 6);
    const bf16* U = (const bf16*)(P.ws + WS_U); bf16* CO = (bf16*)(P.ws + WS_CO);
    LAS bf16* ul = (LAS bf16*)(lds);
    LAS float* yl = (LAS float*)(lds + 65536);
    float w[CWID];
#pragma unroll
    for (int j = 0; j < CWID; ++j) w[j] = P.w_dw[j * CCH + tid];
    const float bdw = P.b_dw[tid];
    f32x4 lg[2], lb[2];
    lg[0] = *(const f32x4*)(P.conv_ln_g + 8 * lane); lg[1] = *(const f32x4*)(P.conv_ln_g + 8 * lane + 4);
    lb[0] = *(const f32x4*)(P.conv_ln_b + 8 * lane); lb[1] = *(const f32x4*)(P.conv_ln_b + 8 * lane + 4);
    for (int ch = blockIdx.x; ch < M / 32; ch += G) {
        const int t0 = ch * 32;
        for (int i = tid; i < 62 * 64; i += 512) { const int r = i >> 6, c8 = i & 63; const int t = t0 - 30 + r;
            v4u v = (v4u){0u, 0u, 0u, 0u}; if (t >= 0) v = *(const GAS v4u*)(U + (size_t)t * CCH + c8 * 8);
            *(LAS v4u*)(ul + r * CCH + c8 * 8) = v; }
        __syncthreads();
        float uu[62];
#pragma unroll
        for (int r = 0; r < 62; ++r) uu[r] = bf2f(ul[r * CCH + tid]);
        float acc[32];
#pragma unroll
        for (int i = 0; i < 32; ++i) { float a = bdw;
#pragma unroll
            for (int j = 0; j < CWID; ++j) a += w[j] * uu[i + j];
            acc[i] = a; }
#pragma unroll
        for (int i = 0; i < 32; ++i) yl[i * CCH + tid] = acc[i];
        __syncthreads();
#pragma unroll
        for (int q = 0; q < 4; ++q) { const int tt = wave + 8 * q;
            f32x4 a = *(const LAS f32x4*)(yl + tt * CCH + 8 * lane), b = *(const LAS f32x4*)(yl + tt * CCH + 8 * lane + 4);
            const float mean = wave_sum((a[0] + a[1]) + (a[2] + a[3]) + (b[0] + b[1]) + (b[2] + b[3])) * (1.0f / CCH);
            a = a - mean; b = b - mean;
            const float var = wave_sum((a[0] * a[0] + a[1] * a[1]) + (a[2] * a[2] + a[3] * a[3]) + (b[0] * b[0] + b[1] * b[1]) + (b[2] * b[2] + b[3] * b[3])) * (1.0f / CCH);
            const float rstd = 1.0f / sqrtf(var + LN_EPS);
            a = a * rstd * lg[0] + lb[0]; b = b * rstd * lg[1] + lb[1];
            a = a * sig4(a); b = b * sig4(b);
            *(GAS v4u*)(CO + (size_t)(t0 + tt) * CCH + 8 * lane) = pack8(a, b); }
        __syncthreads();
    }
}

constexpr int IX_CAP = 640, IX_LIM = IX_CAP - 32;
__device__ __forceinline__ float key2f(unsigned k) { const unsigned u = (k & 0x80000000u) ? (k & 0x7fffffffu) : ~k; return __builtin_bit_cast(float, u); }
__device__ __forceinline__ int lanes_below(unsigned long long m) { return (int)__builtin_amdgcn_mbcnt_hi((unsigned)(m >> 32), __builtin_amdgcn_mbcnt_lo((unsigned)m, 0u)); }
template <int LOWBIT>
__device__ __forceinline__ float ix_compact2(LAS float* v, LAS unsigned short* ix, int& n, int lane) {
    unsigned key[10]; unsigned id[10];
#pragma unroll
    for (int j = 0; j < 10; ++j) { const int i = j * 64 + lane; const bool ok = i < n; key[j] = ok ? f2key(v[ok ? i : 0]) : 0u; id[j] = ok ? (unsigned)ix[ok ? i : 0] : 0u; }
    unsigned p = 0u;
#pragma nounroll
    for (int b = 31; b >= LOWBIT; --b) { const unsigned cand = p | (1u << b); int c = 0;
#pragma unroll
        for (int j = 0; j < 10; ++j) c += __builtin_popcountll(__ballot(key[j] >= cand));
        p = (c >= TOPK) ? cand : p; }
    int kept = 0, ties = 0, ngt = 0;
#pragma unroll
    for (int j = 0; j < 10; ++j) ngt += __builtin_popcountll(__ballot(key[j] > p));
    const int tiecap = (LOWBIT == 0) ? TOPK - ngt : 0x7fffffff;
#pragma unroll
    for (int j = 0; j < 10; ++j) { const bool gt = key[j] > p, eq = key[j] == p && p != 0u;
        const unsigned long long meq = __ballot(eq); const bool keepeq = eq && (ties + lanes_below(meq) < tiecap); ties += __builtin_popcountll(meq);
        const bool keep = gt || keepeq; const unsigned long long mk = __ballot(keep); const int pos = kept + lanes_below(mk);
        if (keep) { v[pos] = key2f(key[j]); ix[pos] = (unsigned short)id[j]; }
        kept += __builtin_popcountll(mk); }
    LDS_WAIT();
    n = kept;
    return key2f(p);
}

constexpr int IX3_LIM = IX_CAP - 128;
template <int PROBE> __device__ __forceinline__ void ph_index_fast3(const Ptrs& P, LAS unsigned char* lds, int G) {
    const int tid = threadIdx.x, lane = tid & 63, wave = __builtin_amdgcn_readfirstlane(tid >> 6), l32 = lane & 31, hi = lane >> 5;
    const bf16* QI = (const bf16*)(P.ws + WS_QI); const bf16* KI = (const bf16*)(P.ws + WS_KI); const float* WI = (const float*)(P.ws + WS_WI);
    unsigned* MASK = (unsigned*)(P.ws + (PROBE ? WS_T : WS_MASK));
    LAS unsigned char* wl = lds + wave * 16384;
    LAS float* vals = (LAS float*)wl;
    LAS unsigned short* idxs = (LAS unsigned short*)(wl + 10240);
    LAS unsigned* hist = (LAS unsigned*)(wl + 15360);
    LAS unsigned* bm = (LAS unsigned*)wl;
    LAS float* dumv = (LAS float*)(wl + 15360) + lane; LAS unsigned short* dumi = (LAS unsigned short*)(wl + 15360 + 256) + lane;
    const int rho = l32, jA = 2 * ((rho >> 2) & 1) + (rho >> 4), headA = 4 * ((rho >> 3) & 1) + (rho & 3);
    const bf16* kgl = KI + (size_t)lane * 8;
    for (int b2 = blockIdx.x; b2 < 256; b2 += G)
        for (int half = 0; half < 2; ++half) {
            const int qblk = half ? 511 - b2 : b2, t0 = qblk * 32 + wave * 4;
            bf16x8 A[4];
#pragma unroll
            for (int ks = 0; ks < 4; ++ks) A[ks] = *(const GAS bf16x8*)(QI + (size_t)(t0 + jA) * 512 + headA * 64 + ks * 16 + hi * 8);
            float w[2][8];
#pragma unroll
            for (int jj = 0; jj < 2; ++jj) { const f32x4 a = *(const GAS f32x4*)(WI + (size_t)(t0 + 2 * hi + jj) * 8), b = *(const GAS f32x4*)(WI + (size_t)(t0 + 2 * hi + jj) * 8 + 4);
                w[jj][0] = a[0]; w[jj][1] = a[1]; w[jj][2] = a[2]; w[jj][3] = a[3]; w[jj][4] = b[0]; w[jj][5] = b[1]; w[jj][6] = b[2]; w[jj][7] = b[3]; }
            int cnt0 = 0, cnt1 = 0, cnt2 = 0, cnt3 = 0; float tau0 = (PROBE == 2) ? INFINITY : -INFINITY, tau1 = tau0, tau2 = tau0, tau3 = tau0;
            const int nkt = (t0 >> 5) + 1, qt0 = t0 + 2 * hi;
            bf16x8 B[4][4];
#define IX_LOAD4(j, tile) do { const char* a_ = (const char*)kgl + (size_t)(tile) * 4096; \
                asm volatile("global_load_dwordx4 %0, %4, off\n\tglobal_load_dwordx4 %1, %4, off offset:1024\n\tglobal_load_dwordx4 %2, %4, off offset:2048\n\tglobal_load_dwordx4 %3, %4, off offset:3072" \
                    : "=&v"(B[j][0]), "=&v"(B[j][1]), "=&v"(B[j][2]), "=&v"(B[j][3]) : "v"(a_) : "memory"); } while (0)
#define IX_WAIT4(j) asm volatile("s_waitcnt vmcnt(12)" : "+v"(B[j][0]), "+v"(B[j][1]), "+v"(B[j][2]), "+v"(B[j][3]) :: "memory")
            asm volatile("" :: "v"(A[0]), "v"(A[1]), "v"(A[2]), "v"(A[3]), "v"(w[0][0]), "v"(w[0][4]), "v"(w[1][0]), "v"(w[1][4]));
#pragma unroll
            for (int j = 0; j < 4; ++j) { const int kk = (PROBE == 1) ? 0 : (j < nkt ? j : 0); IX_LOAD4(j, kk); }
            for (int kt = 0; kt < nkt + 4; kt += 4) {
#pragma unroll
                for (int jp = 0; jp < 2; ++jp) {
                    const int ja = 2 * jp, jb = 2 * jp + 1, ta = kt + ja, tb = kt + jb;
                    if (ta < nkt) {
                        f32x16 accA, accB;
#pragma unroll
                        for (int i = 0; i < 16; ++i) { accA[i] = 0.f; accB[i] = 0.f; }
                        asm volatile("s_waitcnt vmcnt(8)" : "+v"(B[ja][0]), "+v"(B[ja][1]), "+v"(B[ja][2]), "+v"(B[ja][3]), "+v"(B[jb][0]), "+v"(B[jb][1]), "+v"(B[jb][2]), "+v"(B[jb][3]) :: "memory");
#pragma unroll
                        for (int ks = 0; ks < 4; ++ks) { accA = __builtin_amdgcn_mfma_f32_32x32x16_bf16(A[ks], B[ja][ks], accA, 0, 0, 0); accB = __builtin_amdgcn_mfma_f32_32x32x16_bf16(A[ks], B[jb][ks], accB, 0, 0, 0); }
                        { const int kna = (PROBE == 1) ? 0 : ((ta + 4 < nkt) ? ta + 4 : 0), knb = (PROBE == 1) ? 0 : ((tb + 4 < nkt) ? tb + 4 : 0); IX_LOAD4(ja, kna); IX_LOAD4(jb, knb); }
                        float ra[16], rb[16];
#pragma unroll
                        for (int i = 0; i < 16; ++i) { const float a_ = accA[i], b_ = accB[i]; const int ia_ = __float_as_int(a_), ib_ = __float_as_int(b_); ra[i] = __int_as_float(ia_ > 0 ? ia_ : 0); rb[i] = __int_as_float(ib_ > 0 ? ib_ : 0); }
                        float sA0 = w[0][0] * ra[0], sA1 = w[1][0] * ra[8], sB0 = w[0][0] * rb[0], sB1 = w[1][0] * rb[8];
#pragma unroll
                        for (int h = 1; h < 8; ++h) { sA0 = __builtin_fmaf(w[0][h], ra[h], sA0); sA1 = __builtin_fmaf(w[1][h], ra[8 + h], sA1); sB0 = __builtin_fmaf(w[0][h], rb[h], sB0); sB1 = __builtin_fmaf(w[1][h], rb[8 + h], sB1); }
                        const int keyA = ta * 32 + l32, keyB = tb * 32 + l32;
                        const float th0 = hi ? tau2 : tau0, th1 = hi ? tau3 : tau1;
                        const bool pA0 = (sA0 > th0) && (keyA <= qt0), pA1 = (sA1 > th1) && (keyA <= qt0 + 1), pB0 = (sB0 > th0) && (keyB <= qt0), pB1 = (sB1 > th1) && (keyB <= qt0 + 1);
                        if (__ballot(pA0 || pA1 || pB0 || pB1)) {
#define IX_APPEND(pp, ss, kk, c_lo, c_hi, qq) do { const unsigned long long m_ = __ballot(pp); const unsigned lo_ = (unsigned)m_, hh_ = (unsigned)(m_ >> 32); \
                                const int pos_ = hi ? c_hi + (int)__builtin_amdgcn_mbcnt_hi(hh_, 0u) : c_lo + (int)__builtin_amdgcn_mbcnt_lo(lo_, 0u); const int q_ = 2 * hi + (qq); \
                                LAS float* va_ = (pp) ? vals + q_ * IX_CAP + pos_ : dumv; *va_ = (ss); LAS unsigned short* ia_ = (pp) ? idxs + q_ * IX_CAP + pos_ : dumi; *ia_ = (unsigned short)(kk); \
                                c_lo += __builtin_popcount(lo_); c_hi += __builtin_popcount(hh_); } while (0)
                            IX_APPEND(pA0, sA0, keyA, cnt0, cnt2, 0); IX_APPEND(pA1, sA1, keyA, cnt1, cnt3, 1);
                            IX_APPEND(pB0, sB0, keyB, cnt0, cnt2, 0); IX_APPEND(pB1, sB1, keyB, cnt1, cnt3, 1);
#undef IX_APPEND
                        }
                    }
                }
                const int lim = (kt + 4 >= nkt + 4) ? TOPK : IX3_LIM;
                if (cnt0 > lim || cnt1 > lim || cnt2 > lim || cnt3 > lim) {
                    LDS_WAIT();
#pragma nounroll
                    for (int q = 0; q < 4; ++q) { const int n = q == 0 ? cnt0 : q == 1 ? cnt1 : q == 2 ? cnt2 : cnt3;
                        if (n > lim) { int nn = n; float tn = (lim == TOPK) ? ix_compact2<0>(vals + q * IX_CAP, idxs + q * IX_CAP, nn, lane) : ix_compact2<12>(vals + q * IX_CAP, idxs + q * IX_CAP, nn, lane);
                            if (nn > 384) tn = ix_compact2<0>(vals + q * IX_CAP, idxs + q * IX_CAP, nn, lane);
                            if (q == 0) { tau0 = tn; cnt0 = nn; } else if (q == 1) { tau1 = tn; cnt1 = nn; } else if (q == 2) { tau2 = tn; cnt2 = nn; } else { tau3 = tn; cnt3 = nn; } } }
                }
            }
            LDS_WAIT();
#pragma unroll
            for (int r = 0; r < 8; ++r) *(LAS v4u*)(bm + r * 256 + lane * 4) = (v4u){0u, 0u, 0u, 0u};
            LDS_WAIT();
#pragma nounroll
            for (int q = 0; q < 4; ++q) { const int n = q == 0 ? cnt0 : q == 1 ? cnt1 : q == 2 ? cnt2 : cnt3;
#pragma unroll
                for (int j = 0; j < 4; ++j) { const int i = j * 64 + lane; if (i < n) { const unsigned k = idxs[q * IX_CAP + i]; __hip_atomic_fetch_or(bm + q * 512 + (k >> 5), 1u << (k & 31u), __ATOMIC_RELAXED, __HIP_MEMORY_SCOPE_WAVEFRONT); } } }
            LDS_WAIT();
#pragma unroll
            for (int q = 0; q < 4; ++q)
#pragma unroll
                for (int r = 0; r < 2; ++r) *(GAS v4u*)(MASK + (size_t)(t0 + q) * 512 + r * 256 + lane * 4) = *(const LAS v4u*)(bm + q * 512 + r * 256 + lane * 4);
            LDS_WAIT();
        }
}

__device__ __forceinline__ void ph_attn_slow(const Ptrs& P, int G) {
    const int tid = threadIdx.x, lane = tid & 63, wave = __builtin_amdgcn_readfirstlane(tid >> 6);
    const bf16* Q = (const bf16*)(P.ws + WS_Q); const bf16* K = (const bf16*)(P.ws + WS_K); const bf16* V = (const bf16*)(P.ws + WS_V);
    const unsigned* MASK = (const unsigned*)(P.ws + WS_MASK); const float* RT = (const float*)(P.ws + WS_RT); bf16* AO = (bf16*)(P.ws + WS_AO);
    const int head = lane >> 3, sub = lane & 7, co = head * 64 + sub * 8;
    const int gw = blockIdx.x * NWAVES + wave, NGW = G * NWAVES;
    for (int t = gw; t < M; t += NGW) {
        f32x4 q0, q1; unpack8(*(const GAS v4u*)(Q + (size_t)t * 512 + co), q0, q1);
        float m = -INFINITY, l = 0.f; f32x4 a0 = (f32x4){0.f, 0.f, 0.f, 0.f}, a1 = a0;
        const unsigned* mrow = MASK + (size_t)t * 512; const int nw = (t >> 5) + 1;
        for (int w = 0; w < nw; ++w) {
            unsigned word = __builtin_amdgcn_readfirstlane(mrow[w]);
            while (word) { const int b = __builtin_ctz(word); word &= word - 1u; const int s = 32 * w + b;
                f32x4 k0, k1; unpack8(*(const GAS v4u*)(K + (size_t)s * 512 + co), k0, k1);
                f32x4 v0, v1; unpack8(*(const GAS v4u*)(V + (size_t)s * 512 + co), v0, v1);
                float d = (q0[0] * k0[0] + q0[1] * k0[1]) + (q0[2] * k0[2] + q0[3] * k0[3]) + (q1[0] * k1[0] + q1[1] * k1[1]) + (q1[2] * k1[2] + q1[3] * k1[3]);
                d += __shfl_xor(d, 1); d += __shfl_xor(d, 2); d += __shfl_xor(d, 4);
                int rel = t - s; rel = rel > 127 ? 127 : rel;
                const float x = d + RT[head * 128 + rel];
                const float mn = fmaxf(m, x), scl = __builtin_amdgcn_exp2f(m - mn), p = __builtin_amdgcn_exp2f(x - mn);
                l = l * scl + p; a0 = a0 * scl + v0 * p; a1 = a1 * scl + v1 * p; m = mn; }
        }
        const float inv = 1.0f / l;
        *(GAS v4u*)(AO + (size_t)t * 512 + co) = pack8(a0 * inv, a1 * inv);
    }
}


typedef short v4i16_t __attribute__((ext_vector_type(4)));
__device__ __forceinline__ int crow(int r, int hi) { return (r & 3) + 8 * (r >> 2) + 4 * hi; }
__device__ __forceinline__ v4i16_t vtr(LAS const unsigned char* p) { return __builtin_amdgcn_ds_read_tr16_b64_v4i16((LAS v4i16_t*)p); }
template <int PROBE> __device__ __forceinline__ void ph_attn_fast(const Ptrs& P, LAS unsigned char* lds, int G) {
    const int tid = threadIdx.x, lane = tid & 63, wave = __builtin_amdgcn_readfirstlane(tid >> 6), r32 = lane & 31, hi = lane >> 5;
    const bf16* Q = (const bf16*)(P.ws + WS_Q); const bf16* K = (const bf16*)(P.ws + WS_K); const bf16* V = (const bf16*)(P.ws + WS_V);
    const unsigned* MASK = (const unsigned*)(P.ws + WS_MASK); const float* RT = (const float*)(P.ws + WS_RT); bf16* AO = (bf16*)(P.ws + (PROBE ? WS_T : WS_AO));
    LAS unsigned char* kv = lds;
    LAS float* scr = (LAS float*)(lds + 32768) + wave * 64;
    LAS float* rtl = (LAS float*)(lds + 32768 + 2048);
    const int skey = tid >> 3, scc = tid & 7;
    const int kdst = scc * 1024 + ((skey ^ scc) * 16), vdst = 8192 + (scc >> 2) * 4096 + skey * 64 + (scc & 3) * 16;
    const int vrd = 8192 + ((lane >> 4) & 1) * 32 + (lane & 3) * 8 + (4 * hi + ((lane & 15) >> 2)) * 64;
    int krd[4];
#pragma unroll
    for (int d0 = 0; d0 < 4; ++d0) krd[d0] = (2 * d0 + hi) * 1024 + ((r32 ^ (2 * d0 + hi)) * 16);
    const bf16x8 ones = (bf16x8){0x3F80, 0x3F80, 0x3F80, 0x3F80, 0x3F80, 0x3F80, 0x3F80, 0x3F80};
    for (int c = blockIdx.x; c < 256; c += G)
        for (int half = 0; half < 2; ++half) {
            const int h = c & 7, pp = c >> 3, qb = half ? 63 - pp : pp;
            const int q0 = qb * 256, qw = q0 + wave * 32, q = qw + r32, NT = (qb + 1) * 4;
            __syncthreads();
            if (tid < 128) rtl[tid] = RT[h * 128 + tid] - RT[h * 128 + 127];
            bf16x8 qr[4];
#pragma unroll
            for (int d0 = 0; d0 < 4; ++d0) qr[d0] = *(const GAS bf16x8*)(Q + (size_t)q * 512 + h * 64 + d0 * 16 + hi * 8);
            const bf16* kg = K + (size_t)skey * 512 + h * 64 + scc * 8; const bf16* vg = V + (size_t)skey * 512 + h * 64 + scc * 8;
            const unsigned* mg = MASK + (size_t)q * 512;
            v4u kr = *(const GAS v4u*)kg, vr = *(const GAS v4u*)vg; v2u mk = *(const GAS v2u*)mg;
            *(LAS v4u*)(kv + kdst) = kr; *(LAS v4u*)(kv + vdst) = vr;
            __syncthreads();
            float mh = 0.f; f32x16 o0, o1, os, negm;
#pragma unroll
            for (int i = 0; i < 16; ++i) { o0[i] = 0.f; o1[i] = 0.f; os[i] = 0.f; negm[i] = 0.f; }
            for (int t = 0; t < NT; ++t) {
                LAS unsigned char* kb = kv + (t & 1) * 16384;
                v2u mkn = mk;
                if (t + 1 < NT) { kr = *(const GAS v4u*)(kg + (size_t)(t + 1) * 64 * 512); vr = *(const GAS v4u*)(vg + (size_t)(t + 1) * 64 * 512); mkn = *(const GAS v2u*)(mg + 2 * (t + 1)); }
                bf16x8 kf0[4], kf1[4]; v4i16_t va0[4], va1[4], vb0[4], vb1[4];
#pragma unroll
                for (int d0 = 0; d0 < 4; ++d0) { kf0[d0] = *(const LAS bf16x8*)(kb + krd[d0]); kf1[d0] = *(const LAS bf16x8*)(kb + (krd[d0] ^ 512)); }
#pragma unroll
                for (int ks = 0; ks < 2; ++ks) { va0[ks] = vtr(kb + vrd + ks * 1024); va1[ks] = vtr(kb + vrd + ks * 1024 + 512); vb0[ks] = vtr(kb + vrd + 4096 + ks * 1024); vb1[ks] = vtr(kb + vrd + 4096 + ks * 1024 + 512); }
                __builtin_amdgcn_sched_barrier(0);
                f32x16 p0, p1;
#pragma unroll
                for (int d0 = 0; d0 < 4; ++d0) { p0 = __builtin_amdgcn_mfma_f32_32x32x16_bf16(kf0[d0], qr[d0], d0 == 0 ? negm : p0, 0, 0, 0); p1 = __builtin_amdgcn_mfma_f32_32x32x16_bf16(kf1[d0], qr[d0], d0 == 0 ? negm : p1, 0, 0, 0); }
                if (64 * t + 63 >= qw - 127) {
#pragma unroll
                    for (int r = 0; r < 16; ++r) { const int rel = q - (64 * t + crow(r, hi));
                        if (rel >= 0 && rel < 128) p0[r] += rtl[rel];
                        if (rel >= 32 && rel < 160) p1[r] += rtl[rel - 32]; }
                }
                float rm = __builtin_fmaxf(__builtin_fmaxf(p0[0], p1[0]), p0[1]);
#pragma unroll
                for (int r = 1; r < 16; ++r) rm = __builtin_fmaxf(__builtin_fmaxf(rm, p1[r]), (r + 1 < 16) ? p0[r + 1] : p1[r]);
                rm = __builtin_fmaxf(rm, __shfl_xor(rm, 32));
                const bool need = (t == 0) || (rm > 8.0f);
                if (__ballot(need)) {
                    const float dl = need ? rm : 0.f, sc = __builtin_amdgcn_exp2f(-dl);
                    mh += dl;
#pragma unroll
                    for (int r = 0; r < 16; ++r) { p0[r] -= dl; p1[r] -= dl; negm[r] = -mh; }
                    if (hi == 0) scr[r32] = sc;
                    LDS_WAIT();
#pragma unroll
                    for (int a = 0; a < 4; ++a) { const f32x4 s4 = *(const LAS f32x4*)(scr + 8 * a + 4 * hi);
#pragma unroll
                        for (int j = 0; j < 4; ++j) { o0[4 * a + j] *= s4[j]; o1[4 * a + j] *= s4[j]; os[4 * a + j] *= s4[j]; } }
                }
                const unsigned ml = mk.x >> (4 * hi), mh2 = mk.y >> (4 * hi);
#pragma unroll
                for (int r = 0; r < 16; ++r) { const int cbit = (r & 3) + 8 * (r >> 2);
                    const unsigned e0 = __float_as_uint(__builtin_amdgcn_exp2f(p0[r])), e1 = __float_as_uint(__builtin_amdgcn_exp2f(p1[r]));
                    unsigned s0, s1; asm("v_bfe_i32 %0, %1, %2, 1" : "=v"(s0) : "v"(ml), "n"(cbit)); asm("v_bfe_i32 %0, %1, %2, 1" : "=v"(s1) : "v"(mh2), "n"(cbit));
                    p0[r] = __uint_as_float(e0 & s0); p1[r] = __uint_as_float(e1 & s1); }
                bf16x8 pa[4];
#pragma unroll
                for (int ks = 0; ks < 4; ++ks) { v4u w;
                    if (ks < 2) { w.x = cvt_pk_bf16(p0[8 * ks], p0[8 * ks + 1]); w.y = cvt_pk_bf16(p0[8 * ks + 2], p0[8 * ks + 3]); w.z = cvt_pk_bf16(p0[8 * ks + 4], p0[8 * ks + 5]); w.w = cvt_pk_bf16(p0[8 * ks + 6], p0[8 * ks + 7]); }
                    else { const int k2 = ks - 2; w.x = cvt_pk_bf16(p1[8 * k2], p1[8 * k2 + 1]); w.y = cvt_pk_bf16(p1[8 * k2 + 2], p1[8 * k2 + 3]); w.z = cvt_pk_bf16(p1[8 * k2 + 4], p1[8 * k2 + 5]); w.w = cvt_pk_bf16(p1[8 * k2 + 6], p1[8 * k2 + 7]); }
                    pa[ks] = __builtin_bit_cast(bf16x8, w); }
#pragma unroll
                for (int ks = 2; ks < 4; ++ks) { va0[ks] = vtr(kb + vrd + ks * 1024); va1[ks] = vtr(kb + vrd + ks * 1024 + 512); vb0[ks] = vtr(kb + vrd + 4096 + ks * 1024); vb1[ks] = vtr(kb + vrd + 4096 + ks * 1024 + 512); }
#pragma unroll
                for (int ks = 0; ks < 4; ++ks) {
                    const bf16x8 v0 = (bf16x8){va0[ks][0], va0[ks][1], va0[ks][2], va0[ks][3], va1[ks][0], va1[ks][1], va1[ks][2], va1[ks][3]}, v1 = (bf16x8){vb0[ks][0], vb0[ks][1], vb0[ks][2], vb0[ks][3], vb1[ks][0], vb1[ks][1], vb1[ks][2], vb1[ks][3]};
                    o0 = __builtin_amdgcn_mfma_f32_32x32x16_bf16(pa[ks], v0, o0, 0, 0, 0); o1 = __builtin_amdgcn_mfma_f32_32x32x16_bf16(pa[ks], v1, o1, 0, 0, 0);
                    os = __builtin_amdgcn_mfma_f32_32x32x16_bf16(pa[ks], ones, os, 0, 0, 0); }
                if (t + 1 < NT) { LAS unsigned char* nb = kv + ((t + 1) & 1) * 16384; *(LAS v4u*)(nb + kdst) = kr; *(LAS v4u*)(nb + vdst) = vr; }
                mk = mkn;
                __syncthreads();
            }
            bf16* orow = AO + (size_t)qw * 512 + h * 64 + r32;
#pragma unroll
            for (int a = 0; a < 4; ++a)
#pragma unroll
                for (int j = 0; j < 4; ++j) { const int row = 8 * a + 4 * hi + j; const float inv = 1.0f / os[4 * a + j];
                    orow[(size_t)row * 512] = (bf16)f2bf(o0[4 * a + j] * inv); orow[(size_t)row * 512 + 32] = (bf16)f2bf(o1[4 * a + j] * inv); }
            LDS_WAIT();
        }
}

__device__ __forceinline__ void ln_row(const float* src, const float* g, const float* b, float* dst, bf16* dstb, int lane) {
    const GAS f32x4* xr = (const GAS f32x4*)src + lane;
    f32x4 v[4]; float s = 0.f;
#pragma unroll
    for (int j = 0; j < 4; ++j) { v[j] = xr[64 * j]; s += (v[j][0] + v[j][1]) + (v[j][2] + v[j][3]); }
    const float mean = wave_sum(s) * (1.f / D); float s2 = 0.f;
#pragma unroll
    for (int j = 0; j < 4; ++j) { v[j] = v[j] - mean; s2 += (v[j][0] * v[j][0] + v[j][1] * v[j][1]) + (v[j][2] * v[j][2] + v[j][3] * v[j][3]); }
    const float rstd = 1.f / sqrtf(wave_sum(s2) * (1.f / D) + LN_EPS);
#pragma unroll
    for (int j = 0; j < 4; ++j) { const f32x4 gg = ((const GAS f32x4*)g)[lane + 64 * j], bb = ((const GAS f32x4*)b)[lane + 64 * j]; const f32x4 y = v[j] * rstd * gg + bb;
        ((GAS f32x4*)dst)[lane + 64 * j] = y;
        if (dstb) { v2u w; w.x = cvt_pk_bf16(y[0], y[1]); w.y = cvt_pk_bf16(y[2], y[3]); ((GAS v2u*)dstb)[lane + 64 * j] = w; } }
}
__device__ __forceinline__ void ph_ln1_router(const Ptrs& P, LAS unsigned char* lds, int G) {
    const int tid = threadIdx.x, lane = tid & 63, wave = __builtin_amdgcn_readfirstlane(tid >> 6);
    const float* H1 = (const float*)(P.ws + WS_H1); float* X1 = (float*)(P.ws + WS_X1); bf16* X1B = (bf16*)(P.ws + WS_X1B);
    int* TOPI = (int*)(P.ws + WS_TOPI); float* TOPG = (float*)(P.ws + WS_TOPG); int* CNTCH = (int*)(P.ws + WS_CNTCH);
    LAS float* part = (LAS float*)lds;
    LAS unsigned* hist = (LAS unsigned*)(lds + 32768);
    for (int ch = blockIdx.x; ch < M / 64; ch += G) {
        for (int i = 0; i < 8; ++i) { const size_t row = (size_t)ch * 64 + wave * 8 + i; ln_row(H1 + row * D, P.ln1_g, P.ln1_b, X1 + row * D, X1B + row * D, lane); }
        if (tid < 32) hist[tid] = 0u;
        VM_WAIT(); __syncthreads();
        const int rg = wave >> 2, kq = wave & 3;
        f32x16 acc;
#pragma unroll
        for (int i = 0; i < 16; ++i) acc[i] = 0.f;
        const float* xrow = X1 + ((size_t)ch * 64 + rg * 32 + (lane & 31)) * D + 4 * (lane >> 5);
        const float* wr = P.w_router + (size_t)(4 * (lane >> 5)) * NE + (lane & 31);
        for (int k0 = kq * 256; k0 < kq * 256 + 256; k0 += 8) {
            const f32x4 xa = *(const GAS f32x4*)(xrow + k0);
#pragma unroll
            for (int i = 0; i < 4; ++i) acc = __builtin_amdgcn_mfma_f32_32x32x2f32(xa[i], wr[(size_t)(k0 + i) * NE], acc, 0, 0, 0);
        }
#pragma unroll
        for (int i = 0; i < 16; ++i) part[(wave * 16 + i) * 64 + lane] = acc[i];
        __syncthreads();
        if (tid < 64) {
            const int r = tid, rgg = r >> 5, rho = r & 31, ii = (rho & 3) + 4 * (rho >> 3), lh = 32 * ((rho >> 2) & 1);
            float lg[NE];
#pragma unroll
            for (int e = 0; e < NE; ++e) { float s = P.b_router[e];
#pragma unroll
                for (int q = 0; q < 4; ++q) s += part[((rgg * 4 + q) * 16 + ii) * 64 + lh + e];
                lg[e] = s; }
            float tv[4]; int ti[4];
#pragma unroll
            for (int s = 0; s < 4; ++s) { float best = -INFINITY; int bi = 0;
#pragma unroll
                for (int e = 0; e < NE; ++e) if (lg[e] > best) { best = lg[e]; bi = e; }
                tv[s] = best; ti[s] = bi;
#pragma unroll
                for (int e = 0; e < NE; ++e) if (e == bi) lg[e] = -INFINITY; }
            const float e1 = __expf(tv[1] - tv[0]), e2 = __expf(tv[2] - tv[0]), e3 = __expf(tv[3] - tv[0]); const float inv = 1.0f / (1.0f + e1 + e2 + e3);
            const size_t row = (size_t)ch * 64 + r;
            *(int4*)(TOPI + row * 4) = make_int4(ti[0], ti[1], ti[2], ti[3]);
            *(float4*)(TOPG + row * 4) = make_float4(inv, e1 * inv, e2 * inv, e3 * inv);
#pragma unroll
            for (int s = 0; s < 4; ++s) atomicAdd((unsigned*)&hist[ti[s]], 1u);
        }
        __syncthreads();
        if (tid < 32) CNTCH[ch * 32 + tid] = (int)hist[tid];
        __syncthreads();
    }
}

__device__ __forceinline__ void ph_dispatch(const Ptrs& P, LAS unsigned char* lds, int G) {
    const int tid = threadIdx.x;
    const int* TOPI = (const int*)(P.ws + WS_TOPI); const float* TOPG = (const float*)(P.ws + WS_TOPG); const int* CNTCH = (const int*)(P.ws + WS_CNTCH);
    int* ROWTOK = (int*)(P.ws + WS_ROWTOK); float* ROWGATE = (float*)(P.ws + WS_ROWGATE); int* TOKPOS = (int*)(P.ws + WS_TOKPOS); int* EXPOFF = (int*)(P.ws + WS_EXPOFF);
    LAS int* redT = (LAS int*)lds;
    LAS int* redB = redT + 512;
    LAS int* offs = redB + 512;
    LAS int* tot = offs + 40;
    LAS int* bel = tot + 32;
    LAS int* el = bel + 32;
    for (int ch = blockIdx.x; ch < M / 64; ch += G) {
        { const int e = tid & 31, part = tid >> 5; int T = 0, B = 0;
            for (int c = part * 16; c < part * 16 + 16; ++c) { const int v = CNTCH[c * 32 + e]; T += v; if (c < ch) B += v; }
            redT[part * 32 + e] = T; redB[part * 32 + e] = B; }
        __syncthreads();
        if (tid < 32) { int T = 0, B = 0; for (int q = 0; q < 16; ++q) { T += redT[q * 32 + tid]; B += redB[q * 32 + tid]; } tot[tid] = T; bel[tid] = B; }
        __syncthreads();
        if (tid == 0) { int o = 0; for (int e = 0; e < NE; ++e) { offs[e] = o; o += (tot[e] + 255) & ~255; } offs[NE] = o; }
        if (tid < 256) el[tid] = TOPI[(size_t)ch * 256 + tid];
        __syncthreads();
        if (tid < 256) { const int e = el[tid]; int rank = 0; for (int j = 0; j < tid; ++j) rank += (el[j] == e) ? 1 : 0;
            const int pos = offs[e] + bel[e] + rank; const int row = ch * 64 + (tid >> 2);
            ROWTOK[pos] = row; ROWGATE[pos] = TOPG[(size_t)ch * 256 + tid]; TOKPOS[(size_t)ch * 256 + tid] = pos; }
        if (ch < NE) { const int e = ch; for (int r = offs[e] + tot[e] + tid; r < offs[e + 1]; r += 512) { ROWTOK[r] = 0; ROWGATE[r] = 0.f; } }
        if (ch == 0 && tid <= NE) EXPOFF[tid] = offs[tid];
        __syncthreads();
    }
}

__device__ __forceinline__ void ph_combine(const Ptrs& P, int G) {
    const int tid = threadIdx.x, lane = tid & 63, wave = __builtin_amdgcn_readfirstlane(tid >> 6);
    const float* X1 = (const float*)(P.ws + WS_X1); const bf16* Y = (const bf16*)(P.ws + WS_Y); const int* TOKPOS = (const int*)(P.ws + WS_TOKPOS);
    float* HH = (float*)(P.ws + WS_HH); bf16* HHB = (bf16*)(P.ws + WS_HHB);
    const int gw = blockIdx.x * NWAVES + wave, NGW = G * NWAVES;
    for (int t = gw; t < M; t += NGW) {
        const int4 pos = *(const int4*)(TOKPOS + (size_t)t * 4);
        const int pp[4] = {pos.x, pos.y, pos.z, pos.w};
#pragma unroll
        for (int j = 0; j < 4; ++j) { f32x4 h = ((const GAS f32x4*)(X1 + (size_t)t * D))[lane + 64 * j] * ALPHA;
#pragma unroll
            for (int s = 0; s < 4; ++s) { const v2u w = ((const GAS v2u*)(Y + (size_t)pp[s] * D))[lane + 64 * j]; h[0] += bflo(w.x); h[1] += bfhi(w.x); h[2] += bflo(w.y); h[3] += bfhi(w.y); }
            ((GAS f32x4*)(HH + (size_t)t * D))[lane + 64 * j] = h;
            v2u o; o.x = cvt_pk_bf16(h[0], h[1]); o.y = cvt_pk_bf16(h[2], h[3]); ((GAS v2u*)(HHB + (size_t)t * D))[lane + 64 * j] = o; }
    }
}

__device__ __forceinline__ void ph_ln2(const Ptrs& P, int G) {
    const int tid = threadIdx.x, lane = tid & 63, wave = __builtin_amdgcn_readfirstlane(tid >> 6);
    const float* V2 = (const float*)(P.ws + WS_V2);
    const int gw = blockIdx.x * NWAVES + wave, NGW = G * NWAVES;
    for (int t = gw; t < M; t += NGW) ln_row(V2 + (size_t)t * D, P.ln2_g, P.ln2_b, P.out + (size_t)t * D, nullptr, lane);
}

constexpr int NPHASE = 15;
struct Args { Ptrs p; int ph_lo, ph_hi; };
__global__ void __launch_bounds__(NWAVES * 64, 2) mk_fwd(Args args) {
    extern __shared__ __attribute__((aligned(16))) unsigned char lds_raw[];
    LAS unsigned char* lds = (LAS unsigned char*)lds_raw;
    volatile LAS unsigned* MISC = (volatile LAS unsigned*)(lds + MISC_OFF);
    const Ptrs& P = args.p; unsigned char* ws = P.ws;
    const int tid = threadIdx.x, G = gridDim.x;
    for (int u = tid; u < (LDS_BYTES - LDSCTL_OFF) / 4; u += NWAVES * 64) ((LAS unsigned*)(lds + LDSCTL_OFF))[u] = 0u;
    __syncthreads();
    const int lo = args.ph_lo, hi = args.ph_hi;
    const bool multi = (hi - lo) > 1;
    XcdBarrier bar; bar.bar = (unsigned*)(ws + WS_CTL) + CW_BAR; bar.x = 0; bar.st = nullptr;
    if (multi) bar = xcd_barrier_post((unsigned*)(ws + WS_CTL) + CW_BAR, MISC + 8);
#ifndef PH_MASK
#define PH_MASK 0x7fff
#endif
#define IN(k) ((((PH_MASK) >> (k)) & 1) && lo <= (k) && (k) < hi)
#define SEAM(k) do { if (IN(k) && IN((k) + 1)) xcd_barrier(bar); } while (0)
#ifndef REPEAT_PH
#define REPEAT_PH -1
#endif
#define REP(k) for (int rep_ = 0; rep_ < ((k) == REPEAT_PH ? 2 : 1); ++rep_)
    LAS int* expoff = (LAS int*)(lds + LDSCTL_OFF);

    if (IN(0)) REP(0) { ph_prologue(P, lds, G); SEAM(0); }
    if (IN(1)) REP(1) {
        pg8::Gemm g{(const bf16*)(ws + WS_XB), (const bf16*)(ws + WS_WIN), M, NPROJ, D}; pg8::StaticOrder S; S.init(M, NPROJ, G, (int)blockIdx.x);
        EpiProj E{ws, (const float*)(ws + WS_BIASP)};
        pg8::gemm_phase<EpiProj, pg8::StaticOrder, true, true>(lds + RING_OFF, g, S, E);
        SEAM(1);
    }
    if (IN(2)) REP(2) {
#ifndef NO_CONV
        for (int r2_ = 0; r2_ < (REPEAT_PH == 20 ? 2 : 1); ++r2_) { ph_conv(P, lds, G); __syncthreads(); }
#endif
#ifndef NO_INDEX
#if 1
        for (int r2_ = 0; r2_ < (REPEAT_PH == 21 ? 2 : 1); ++r2_) { ph_index_fast3<0>(P, lds, G); __syncthreads(); }
#ifdef IXPROBE
        ph_index_fast3<IXPROBE>(P, lds, G); __syncthreads();
#endif
#endif
#endif
        SEAM(2); }
    if (IN(3)) REP(3) {
#ifdef SLOW_ATTN
        ph_attn_slow(P, G);
#else
        ph_attn_fast<0>(P, lds, G);
#ifdef ATPROBE
        __syncthreads(); ph_attn_fast<ATPROBE>(P, lds, G);
#endif
#endif
        SEAM(3); }
    if (IN(4)) REP(4) {
        pg8::Gemm g{(const bf16*)(ws + WS_AO), (const bf16*)(ws + WS_WOA), M, D, AW}; pg8::StaticOrder S; S.init(M, D, G, (int)blockIdx.x);
        EpiGated<false> E{(const bf16*)(ws + WS_SG), 0, nullptr, (bf16*)(ws + WS_T)};
        pg8::gemm_phase<EpiGated<false>, pg8::StaticOrder, true, true>(lds + RING_OFF, g, S, E);
        SEAM(4);
    }
    if (IN(5)) REP(5) {
        pg8::Gemm g{(const bf16*)(ws + WS_CO), (const bf16*)(ws + WS_WOC), M, D, CCH}; pg8::StaticOrder S; S.init(M, D, G, (int)blockIdx.x);
        EpiGated<true> E{(const bf16*)(ws + WS_SG), 1024, (const bf16*)(ws + WS_T), (bf16*)(ws + WS_MG)};
        pg8::gemm_phase<EpiGated<true>, pg8::StaticOrder, true, true>(lds + RING_OFF, g, S, E);
        SEAM(5);
    }
    if (IN(6)) REP(6) {
        pg8::Gemm g{(const bf16*)(ws + WS_MG), (const bf16*)(ws + WS_WOUT), M, D, D}; pg8::StaticOrder S; S.init(M, D, G, (int)blockIdx.x);
        EpiRes E{P.x, (float*)(ws + WS_H1)};
        pg8::gemm_phase<EpiRes, pg8::StaticOrder, true, true>(lds + RING_OFF, g, S, E);
        SEAM(6);
    }
    if (IN(7)) REP(7) { ph_ln1_router(P, lds, G); SEAM(7); }
    if (IN(8)) REP(8) { ph_dispatch(P, lds, G); SEAM(8); }
    if (IN(9) || IN(10)) { if (tid <= NE) expoff[tid] = ((const int*)(ws + WS_EXPOFF))[tid]; __syncthreads(); }
    if (IN(9)) REP(9) {
        pg8::Gemm g{(const bf16*)(ws + WS_X1B), (const bf16*)(ws + WS_WGU), RMAX, 2 * DE, D};
        MoeOrder<true> S{expoff, 8, G, (int)blockIdx.x, (const int*)(ws + WS_ROWTOK), D, (size_t)2 * DE * D * 2};
        EpiSwiglu E{(const float*)(ws + WS_BGUP), (bf16*)(ws + WS_HB)};
        pg8::gemm_phase<EpiSwiglu, MoeOrder<true>, true, true>(lds + RING_OFF, g, S, E);
        SEAM(9);
    }
    if (IN(10)) REP(10) {
        pg8::Gemm g{(const bf16*)(ws + WS_HB), (const bf16*)(ws + WS_WD), RMAX, D, DE};
        MoeOrder<false> S{expoff, 4, G, (int)blockIdx.x, nullptr, DE, (size_t)D * DE * 2};
        EpiDown E{P.b_down, (const float*)(ws + WS_ROWGATE), (bf16*)(ws + WS_Y)};
        pg8::gemm_phase<EpiDown, MoeOrder<false>, true, true>(lds + RING_OFF, g, S, E);
        SEAM(10);
    }
    if (IN(11)) REP(11) { ph_combine(P, G); SEAM(11); }
    if (IN(12)) REP(12) {
        pg8::Gemm g{(const bf16*)(ws + WS_PB), (const bf16*)(ws + WS_WPP), M, D, PLE}; pg8::StaticOrder S; S.init(M, D, G, (int)blockIdx.x);
        EpiPlain E{(bf16*)(ws + WS_PP)};
        pg8::gemm_phase<EpiPlain, pg8::StaticOrder, true, true>(lds + RING_OFF, g, S, E);
        SEAM(12);
    }
    if (IN(13)) REP(13) {
        pg8::Gemm g{(const bf16*)(ws + WS_HHB), (const bf16*)(ws + WS_WPG), M, D, D}; pg8::StaticOrder S; S.init(M, D, G, (int)blockIdx.x);
        EpiPle E{(const float*)(ws + WS_HH), (const bf16*)(ws + WS_PP), (float*)(ws + WS_V2)};
        pg8::gemm_phase<EpiPle, pg8::StaticOrder, true, true>(lds + RING_OFF, g, S, E);
        SEAM(13);
    }
    if (IN(14)) REP(14) { ph_ln2(P, G); }
#ifdef DBG_OUT
    if (lo == 15) {
        const size_t gt = (size_t)blockIdx.x * (NWAVES * 64) + tid, NT = (size_t)G * NWAVES * 64;
        for (size_t i = gt; i < (size_t)M * D; i += NT) {
#if DBG_OUT == 1
            P.out[i] = ((const float*)(ws + WS_H1))[i];
#elif DBG_OUT == 2
            P.out[i] = bf2f(((const bf16*)(ws + WS_MG))[i]);
#elif DBG_OUT == 3
            { const size_t r = i >> 10, c = i & 1023; P.out[i] = c < 512 ? bf2f(((const bf16*)(ws + WS_AO))[r * 512 + c]) : bf2f(((const bf16*)(ws + WS_CO))[r * 512 + c - 512]); }
#elif DBG_OUT == 4
            { const size_t r = i >> 10, c = i & 1023; P.out[i] = c < 512 ? (float)(((const unsigned*)(ws + WS_MASK))[r * 512 + c] & 0xffffu) : (float)(((const unsigned*)(ws + WS_MASK))[r * 512 + c - 512] >> 16); }
#elif DBG_OUT == 5
            P.out[i] = ((const float*)(ws + WS_HH))[i];
#elif DBG_OUT == 6
            P.out[i] = ((const float*)(ws + WS_X1))[i];
#elif DBG_OUT == 7
            P.out[i] = bf2f(((const bf16*)(ws + WS_T))[i]);
#elif DBG_OUT == 9
            { const size_t r = i >> 10, c = i & 1023; P.out[i] = c < 512 ? bf2f(((const bf16*)(ws + WS_Q))[r * 512 + c]) : bf2f(((const bf16*)(ws + WS_U))[r * 512 + c - 512]); }
#elif DBG_OUT == 10
            { const size_t r = i >> 10, c = i & 1023; P.out[i] = bf2f(((const bf16*)(ws + WS_WIN))[(3072 + (r & 2047)) * 1024 + c]) + ((const float*)(ws + WS_BIASP))[3072 + (i & 2047)]; }
#elif DBG_OUT == 8
            { const size_t r = i >> 10, c = i & 1023; P.out[i] = bf2f(((const bf16*)(ws + WS_SG))[r * 2048 + c]) + 2.f * bf2f(((const bf16*)(ws + WS_SG))[r * 2048 + 1024 + c]); }
#endif
        }
    }
#endif
#undef IN
#undef SEAM
}

#ifndef MK_ONE_LAUNCH
#define MK_ONE_LAUNCH 1
#endif
extern "C" void kernel_launch(void* const* d_in, const int* in_sizes, int n_in, void* d_out, int out_size, void* d_ws, size_t ws_size, hipStream_t stream) {
    static int grid = 0;
    if (grid == 0) {
        if (n_in != 24 || in_sizes[0] != M * D || out_size != M * D || ws_size < WS_END) { fprintf(stderr, "kernel_launch: unexpected shapes (n_in %d, in0 %d, out %d, ws %zu)\n", n_in, n_in > 0 ? in_sizes[0] : -1, out_size, ws_size); grid = -1; return; }
        int dev = 0, cus = 0, per_cu = 0;
        if (hipGetDevice(&dev) != hipSuccess || hipDeviceGetAttribute(&cus, hipDeviceAttributeMultiprocessorCount, dev) != hipSuccess) { grid = -1; return; }
        if (hipFuncSetAttribute((const void*)mk_fwd, hipFuncAttributeMaxDynamicSharedMemorySize, LDS_BYTES) != hipSuccess) { fprintf(stderr, "kernel_launch: hipFuncSetAttribute failed\n"); grid = -1; return; }
        if (hipOccupancyMaxActiveBlocksPerMultiprocessor(&per_cu, (const void*)mk_fwd, NWAVES * 64, LDS_BYTES) != hipSuccess || per_cu < 1) fprintf(stderr, "kernel_launch: occupancy query reports %d\n", per_cu);
        (void)hipGetLastError();
        grid = cus;
    }
    if (grid < 0) return;
    if (hipMemsetAsync((char*)d_ws + WS_CTL, 0, CTL_ZERO_BYTES, stream) != hipSuccess) return;
    Args a{};
    const float** pp = (const float**)&a.p;
    for (int i = 0; i < 24; ++i) pp[i] = (const float*)d_in[i];
    a.p.out = (float*)d_out; a.p.ws = (unsigned char*)d_ws;
#if MK_ONE_LAUNCH
    a.ph_lo = 0; a.ph_hi = NPHASE;
    hipLaunchKernelGGL(mk_fwd, dim3(grid), dim3(NWAVES * 64), LDS_BYTES, stream, a);
#else
#ifndef NRUN
#define NRUN NPHASE
#endif
#ifdef DBG_OUT
    for (int ph = 0; ph <= (DBG_OUT <= 4 ? (DBG_OUT == 1 ? 6 : DBG_OUT == 2 ? 5 : 3) : (DBG_OUT == 5 ? 11 : DBG_OUT == 6 ? 7 : DBG_OUT == 7 ? 4 : 1)); ++ph) { a.ph_lo = ph; a.ph_hi = ph + 1; hipLaunchKernelGGL(mk_fwd, dim3(grid), dim3(NWAVES * 64), LDS_BYTES, stream, a); }
    a.ph_lo = 15; a.ph_hi = 16; hipLaunchKernelGGL(mk_fwd, dim3(grid), dim3(NWAVES * 64), LDS_BYTES, stream, a);
    return;
#endif
    for (int ph = 0; ph < NRUN; ++ph) { a.ph_lo = ph; a.ph_hi = ph + 1; hipLaunchKernelGGL(mk_fwd, dim3(grid), dim3(NWAVES * 64), LDS_BYTES, stream, a); }
#endif
}
```
